# Optimizing an MI355X kernel written in HIP

```python
import math
import jax, jax.numpy as jnp
from jax import lax
import numpy as np

D_MODEL = 1024
BATCH = 32
SEQ = 256
DEPTH = 4
DEC_BATCH = 2
DEC_SEQ = 2048
PAST_LEN = 256

GRID_W = 64
N_MIXERS = 3
N_LAYERS_DA = (DEPTH + 2) // 3
N_LAYERS_RWKV = (DEPTH + 1) // 3
N_LAYERS_SWA = DEPTH // 3
Q_BLOCK = 128
ROPE_BASE = 10000.0
NORM_EPS = 1e-6
D_FF = 4 * D_MODEL
NEG_INF = -1e30
DA_HEAD_DIM = 64
DA_HEADS = D_MODEL // (2 * DA_HEAD_DIM)
RWKV_HEAD = 64
RWKV_HEADS = D_MODEL // RWKV_HEAD
RWKV_DECAY_LORA = 64
RWKV_ICLR_LORA = 64
RWKV_GATE_LORA = 128
RWKV_GN_EPS = 64e-5
SWA_HEAD_DIM = 64
SWA_HEADS = D_MODEL // SWA_HEAD_DIM
SWA_KV_HEADS = SWA_HEADS // 4
SWA_GROUP = SWA_HEADS // SWA_KV_HEADS
WINDOW = 128

kernel_name = 'hybrid_diffusion_prefix_trunk_step'

f32 = jnp.float32


def rms_norm(x, gain=None):
    xf = x.astype(f32)
    y = xf * lax.rsqrt(jnp.mean(xf * xf, axis=-1, keepdims=True) + NORM_EPS)
    if gain is not None:
        y = y * gain.astype(f32)
    return y.astype(x.dtype)


def modulation(cond, ada_w, ada_b):
    m = jax.nn.silu(cond) @ ada_w + ada_b
    return jnp.split(m[:, None, :], 6, axis=-1)


def adaln(x, shift, scale):
    return rms_norm(x) * (1 + scale) + shift


def squared_relu_mlp(h, w1, w2):
    return jnp.square(jax.nn.relu(h @ w1)) @ w2


def axial_rope(n_tok, head_dim):
    n_rows = n_tok // GRID_W
    rows = jnp.broadcast_to(jnp.arange(n_rows, dtype=f32)[:, None], (n_rows, GRID_W)).reshape(-1)
    cols = jnp.broadcast_to(jnp.arange(GRID_W, dtype=f32)[None, :], (n_rows, GRID_W)).reshape(-1)
    n_freq = head_dim // 4
    inv = ROPE_BASE ** (-jnp.arange(n_freq, dtype=f32) / n_freq)
    ang = jnp.concatenate([rows[:, None] * inv, cols[:, None] * inv], axis=-1)
    return jnp.cos(ang), jnp.sin(ang)


def apply_rope(x, cos, sin):
    shape = (cos.shape[0],) + (1,) * (x.ndim - 3) + (cos.shape[1],)
    cos = cos.reshape(shape)
    sin = sin.reshape(shape)
    x1, x2 = jnp.split(x.astype(f32), 2, axis=-1)
    return jnp.concatenate([x1 * cos - x2 * sin, x2 * cos + x1 * sin], axis=-1).astype(x.dtype)


def map_query_blocks(fn, q):
    b, t = q.shape[:2]
    nb = t // Q_BLOCK
    qb = jnp.moveaxis(q.reshape(b, nb, Q_BLOCK, *q.shape[2:]), 1, 0)
    out = jnp.moveaxis(lax.map(fn, qb), 0, 1)
    return out.reshape(b, t, *out.shape[3:])


def da_project(h, p):
    b, t, _ = h.shape
    q, k, v = jnp.split(h @ p['wqkv'], 3, axis=-1)
    q = rms_norm(q.reshape(b, t, DA_HEADS, 2, DA_HEAD_DIM), p['q_norm'])
    k = rms_norm(k.reshape(b, t, DA_HEADS, 2, DA_HEAD_DIM), p['k_norm'])
    v = v.reshape(b, t, DA_HEADS, 2 * DA_HEAD_DIM)
    return q, k, v


def da_lambda_value(lam, lam_init):
    lp = lam.astype(f32)
    return jnp.exp(jnp.sum(lp[0] * lp[1])) - jnp.exp(jnp.sum(lp[2] * lp[3])) + lam_init


def diff_attention(q, k, v, lam):
    scale = DA_HEAD_DIM ** -0.5

    def block(qb):
        s = jnp.einsum('bqhmd,bshmd->bhmqs', qb, k).astype(f32) * scale
        pr = jax.nn.softmax(s, axis=-1)
        pr = pr[:, :, 0] - lam * pr[:, :, 1]
        return jnp.einsum('bhqs,bshe->bqhe', pr, v).astype(v.dtype)

    return map_query_blocks(block, q)


def da_output(o, p, lam_init):
    b, t = o.shape[:2]
    o = rms_norm(o, p['subln']) * (1.0 - lam_init)
    return o.reshape(b, t, -1) @ p['wo']


def da_context(h, p, lam_init):
    b, t, _ = h.shape
    q, k, v = da_project(h, p)
    lam = da_lambda_value(p['lam'], lam_init)
    o = diff_attention(q, k, v, lam)
    return da_output(o, p, lam_init), k.reshape(b, t, DA_HEADS, 2 * DA_HEAD_DIM), v


def da_latent(h, ctx_k, ctx_v, cos, sin, p, lam_init):
    b = h.shape[0]
    q, k, v = da_project(h, p)
    q = apply_rope(q, cos, sin)
    k = apply_rope(k, cos, sin)
    n_ctx = ctx_k.shape[1]
    keys = jnp.concatenate([ctx_k.reshape(b, n_ctx, DA_HEADS, 2, DA_HEAD_DIM).astype(k.dtype), k], axis=1)
    vals = jnp.concatenate([ctx_v.astype(v.dtype), v], axis=1)
    lam = da_lambda_value(p['lam'], lam_init)
    o = diff_attention(q, keys, vals, lam)
    return da_output(o, p, lam_init)


def swa_project(h, p):
    b, t, _ = h.shape
    nq = SWA_HEADS * SWA_HEAD_DIM
    nk = SWA_KV_HEADS * SWA_HEAD_DIM
    q, k, v = jnp.split(h @ p['wqkv'], [nq, nq + nk], axis=-1)
    q = rms_norm(q.reshape(b, t, SWA_KV_HEADS, SWA_GROUP, SWA_HEAD_DIM), p['q_norm'])
    k = rms_norm(k.reshape(b, t, SWA_KV_HEADS, SWA_HEAD_DIM), p['k_norm'])
    v = v.reshape(b, t, SWA_KV_HEADS, SWA_HEAD_DIM)
    return q, k, v


def swa_context(h, p):
    b, t, _ = h.shape
    q, k, v = swa_project(h, p)
    scale = SWA_HEAD_DIM ** -0.5
    sink = p['sink'].astype(f32).reshape(SWA_KV_HEADS, SWA_GROUP)

    def block(qb):
        s = jnp.einsum('bqjgd,bsjd->bjgqs', qb, k).astype(f32) * scale
        sk = jnp.broadcast_to(sink[None, :, :, None, None], s.shape[:-1] + (1,))
        pr = jax.nn.softmax(jnp.concatenate([s, sk], axis=-1), axis=-1)[..., :-1]
        return jnp.einsum('bjgqs,bsjd->bqjgd', pr, v).astype(v.dtype)

    o = map_query_blocks(block, q)
    return o.reshape(b, t, -1) @ p['wo'], k, v


def swa_latent(h, ctx_k, ctx_v, cos, sin, p):
    b, t, _ = h.shape
    q, k, v = swa_project(h, p)
    q = apply_rope(q, cos, sin)
    k = apply_rope(k, cos, sin)
    scale = SWA_HEAD_DIM ** -0.5
    nb = t // WINDOW
    qb = q.reshape(b, nb, WINDOW, SWA_KV_HEADS, SWA_GROUP, SWA_HEAD_DIM)
    pad = ((0, 0), (WINDOW, WINDOW), (0, 0), (0, 0))
    kp = jnp.pad(k, pad).reshape(b, nb + 2, WINDOW, SWA_KV_HEADS, SWA_HEAD_DIM)
    vp = jnp.pad(v, pad).reshape(b, nb + 2, WINDOW, SWA_KV_HEADS, SWA_HEAD_DIM)
    kband = jnp.concatenate([kp[:, :-2], kp[:, 1:-1], kp[:, 2:]], axis=2)
    vband = jnp.concatenate([vp[:, :-2], vp[:, 1:-1], vp[:, 2:]], axis=2)
    s_loc = jnp.einsum('bnqjgd,bnsjd->bnjgqs', qb, kband).astype(f32) * scale
    qi = jnp.arange(WINDOW)[:, None]
    si = jnp.arange(3 * WINDOW)[None, :]
    rel = si - qi
    in_window = (rel >= 0) & (rel <= 2 * WINDOW)
    key_pos = (jnp.arange(nb)[:, None, None] - 1) * WINDOW + si[None]
    valid = in_window[None] & (key_pos >= 0) & (key_pos < t)
    s_loc = jnp.where(valid[None, :, None, None], s_loc, NEG_INF)
    s_ctx = jnp.einsum('bnqjgd,bljd->bnjgql', qb, ctx_k.astype(q.dtype)).astype(f32) * scale
    sink = p['sink'].astype(f32).reshape(SWA_KV_HEADS, SWA_GROUP)
    sk = jnp.broadcast_to(sink[None, None, :, :, None, None], s_loc.shape[:-1] + (1,))
    n_ctx = ctx_k.shape[1]
    pr = jax.nn.softmax(jnp.concatenate([s_ctx, s_loc, sk], axis=-1), axis=-1)
    o = (jnp.einsum('bnjgql,bljd->bnqjgd', pr[..., :n_ctx], ctx_v.astype(f32))
         + jnp.einsum('bnjgqs,bnsjd->bnqjgd', pr[..., n_ctx:n_ctx + 3 * WINDOW], vband))
    return o.reshape(b, t, -1).astype(h.dtype) @ p['wo']


def token_shift_delta(x):
    xp = jnp.pad(x, ((0, 0), (1, 1), (0, 0)))
    return 0.5 * (xp[:, :-2] + xp[:, 2:]) - x


def wkv_scan(s0, r, w, k, v, a, bb, reverse):
    seq = tuple(jnp.moveaxis(z.astype(f32), 1, 0) for z in (r, w, k, v, a, bb))

    def step(s, inp):
        rt, wt, kt, vt, at, bt = inp
        sa = jnp.einsum('bhvk,bhk->bhv', s, at)
        s = s * wt[:, :, None, :] + sa[..., None] * bt[:, :, None, :] + vt[..., None] * kt[:, :, None, :]
        return s, jnp.einsum('bhvk,bhk->bhv', s, rt)

    s_fin, ys = lax.scan(step, s0.astype(f32), seq, reverse=reverse)
    return s_fin, jnp.moveaxis(ys, 0, 1)


def rwkv_mixer(h, s0, p):
    b, t, d = h.shape
    heads = lambda z: z.reshape(*z.shape[:-1], RWKV_HEADS, RWKV_HEAD)
    xx = token_shift_delta(h)
    xs = h[None] + xx[None] * p['mu'][:, None, None, :]
    r, k, v = jnp.einsum('mbtd,mde->mbte', xs[:3], p['wrkv'])
    xw, xa, xg = xs[3], xs[4], xs[5]
    w_lora = jnp.einsum('zbtr,zrd->zbtd', jnp.tanh(jnp.einsum('btd,zdr->zbtr', xw, p['w1'])), p['w2'])
    w_log = -jax.nn.softplus(-(p['w0'][:, None, None, :] + w_lora).astype(f32)) - 0.5
    decay = jnp.exp(-jnp.exp(w_log))
    a_lora = jnp.einsum('zbtr,zrd->zbtd', jnp.einsum('btd,zdr->zbtr', xa, p['a1']), p['a2'])
    a = jax.nn.sigmoid((p['a0'][:, None, None, :] + a_lora).astype(f32))
    g = jax.nn.sigmoid(xg @ p['g1']) @ p['g2']
    kk = heads((k * p['k_k']).astype(f32))
    kk = kk * lax.rsqrt(jnp.maximum(jnp.sum(kk * kk, axis=-1, keepdims=True), 1e-24))
    kd = heads(k.astype(f32)[None] * (1 + (a - 1) * p['k_a'].astype(f32)))
    b_vec = kk[None] * heads(a)
    r_h = heads(r.astype(f32))
    v_h = heads(v.astype(f32))
    s_f, y_f = wkv_scan(s0[:, 0], r_h, heads(decay[0]), kd[0], v_h, -kk, b_vec[0], False)
    s_b, y_b = wkv_scan(s0[:, 1], r_h, heads(decay[1]), kd[1], v_h, -kk, b_vec[1], True)
    y = y_f + y_b
    mu = jnp.mean(y, axis=-1, keepdims=True)
    var = jnp.mean(jnp.square(y - mu), axis=-1, keepdims=True)
    y = (y - mu) * lax.rsqrt(var + RWKV_GN_EPS) * heads(p['ln_w'].astype(f32)) + heads(p['ln_b'].astype(f32))
    bonus = jnp.sum(r_h[None] * kd * p['r_k'].astype(f32), axis=-1, keepdims=True).sum(axis=0) * v_h
    out = ((y + bonus).reshape(b, t, d).astype(h.dtype) * g) @ p['wo']
    return out, jnp.stack([s_f, s_b], axis=1).astype(h.dtype)


def setup_inputs(seed: int = 0) -> dict:
    key = jax.random.key(seed)
    ks = iter(jax.random.split(key, 64))
    D = D_MODEL

    def nrm(shape, scale):
        return scale * jax.random.normal(next(ks), shape, f32)

    def uni(shape, lo, hi):
        return jax.random.uniform(next(ks), shape, f32, lo, hi)

    nq = SWA_HEADS * SWA_HEAD_DIM
    return {
        'x_prompt': nrm((BATCH, SEQ, D), 1.0),
        'x_sample': nrm((DEC_BATCH, DEC_SEQ, D), 1.0),
        'cache_da_k': nrm((DEC_BATCH, N_LAYERS_DA, PAST_LEN, DA_HEADS, 2 * DA_HEAD_DIM), 1.0),
        'cache_da_v': nrm((DEC_BATCH, N_LAYERS_DA, PAST_LEN, DA_HEADS, 2 * DA_HEAD_DIM), 1.0),
        'state_rwkv': nrm((DEC_BATCH, N_LAYERS_RWKV, 2, RWKV_HEADS, RWKV_HEAD, RWKV_HEAD), 1.0),
        'cache_swa_k': nrm((DEC_BATCH, N_LAYERS_SWA, PAST_LEN, SWA_KV_HEADS, SWA_HEAD_DIM), 1.0),
        'cache_swa_v': nrm((DEC_BATCH, N_LAYERS_SWA, PAST_LEN, SWA_KV_HEADS, SWA_HEAD_DIM), 1.0),
        'c': nrm((DEC_BATCH, D), 1.0),
        'c_ctx': nrm((D,), 1.0),
        'ada_w': nrm((DEPTH, D, 6 * D), 0.5 * D ** -0.5),
        'ada_b': nrm((DEPTH, 6 * D), 0.02),
        'mlp_w1': nrm((DEPTH, D, D_FF), D ** -0.5),
        'mlp_w2': nrm((DEPTH, D_FF, D), D_FF ** -0.5),
        'da_wqkv': nrm((N_LAYERS_DA, D, 3 * D), D ** -0.5),
        'da_q_norm': 1.0 + nrm((N_LAYERS_DA, DA_HEAD_DIM), 0.02),
        'da_k_norm': 1.0 + nrm((N_LAYERS_DA, DA_HEAD_DIM), 0.02),
        'da_lambda': nrm((N_LAYERS_DA, 4, DA_HEAD_DIM), 0.1),
        'da_subln': 1.0 + nrm((N_LAYERS_DA, 2 * DA_HEAD_DIM), 0.02),
        'da_wo': nrm((N_LAYERS_DA, D, D), D ** -0.5),
        'rwkv_mu': uni((N_LAYERS_RWKV, 6, D), 0.0, 1.0),
        'rwkv_wrkv': nrm((N_LAYERS_RWKV, 3, D, D), D ** -0.5),
        'rwkv_w0': uni((N_LAYERS_RWKV, 2, D), -6.0, 1.0),
        'rwkv_w1': nrm((N_LAYERS_RWKV, 2, D, RWKV_DECAY_LORA), D ** -0.5),
        'rwkv_w2': nrm((N_LAYERS_RWKV, 2, RWKV_DECAY_LORA, D), 0.5 * RWKV_DECAY_LORA ** -0.5),
        'rwkv_a0': nrm((N_LAYERS_RWKV, 2, D), 0.1),
        'rwkv_a1': nrm((N_LAYERS_RWKV, 2, D, RWKV_ICLR_LORA), D ** -0.5),
        'rwkv_a2': nrm((N_LAYERS_RWKV, 2, RWKV_ICLR_LORA, D), 0.5 * RWKV_ICLR_LORA ** -0.5),
        'rwkv_g1': nrm((N_LAYERS_RWKV, D, RWKV_GATE_LORA), D ** -0.5),
        'rwkv_g2': nrm((N_LAYERS_RWKV, RWKV_GATE_LORA, D), RWKV_GATE_LORA ** -0.5),
        'rwkv_k_k': 0.85 + nrm((N_LAYERS_RWKV, D), 0.02),
        'rwkv_k_a': 1.0 + nrm((N_LAYERS_RWKV, D), 0.02),
        'rwkv_r_k': nrm((N_LAYERS_RWKV, RWKV_HEADS, RWKV_HEAD), 0.1),
        'rwkv_ln_w': 1.0 + nrm((N_LAYERS_RWKV, D), 0.02),
        'rwkv_ln_b': nrm((N_LAYERS_RWKV, D), 0.02),
        'rwkv_wo': nrm((N_LAYERS_RWKV, D, D), D ** -0.5),
        'swa_wqkv': nrm((N_LAYERS_SWA, D, nq + 2 * SWA_KV_HEADS * SWA_HEAD_DIM), D ** -0.5),
        'swa_q_norm': 1.0 + nrm((N_LAYERS_SWA, SWA_HEAD_DIM), 0.02),
        'swa_k_norm': 1.0 + nrm((N_LAYERS_SWA, SWA_HEAD_DIM), 0.02),
        'swa_sink': nrm((N_LAYERS_SWA, SWA_HEADS), 0.5),
        'swa_wo': nrm((N_LAYERS_SWA, nq, D), nq ** -0.5),
    }


def reference(x_prompt, x_sample, cache_da_k, cache_da_v, state_rwkv, cache_swa_k, cache_swa_v, c,
              c_ctx, ada_w, ada_b, mlp_w1, mlp_w2,
              da_wqkv, da_q_norm, da_k_norm, da_lambda, da_subln, da_wo,
              rwkv_mu, rwkv_wrkv, rwkv_w0, rwkv_w1, rwkv_w2, rwkv_a0, rwkv_a1, rwkv_a2,
              rwkv_g1, rwkv_g2, rwkv_k_k, rwkv_k_a, rwkv_r_k, rwkv_ln_w, rwkv_ln_b, rwkv_wo,
              swa_wqkv, swa_q_norm, swa_k_norm, swa_sink, swa_wo):
    x_ctx = x_prompt
    x_lat = x_sample
    n_lat = x_sample.shape[1]
    cos_da, sin_da = axial_rope(n_lat, DA_HEAD_DIM)
    cos_swa, sin_swa = axial_rope(n_lat, SWA_HEAD_DIM)
    b_ctx = x_prompt.shape[0]
    da_k_list, da_v_list, rwkv_list, swa_k_list, swa_v_list = [], [], [], [], []
    for i in range(DEPTH):
        kind = i % N_MIXERS
        j = i // N_MIXERS
        sh_m_c, sc_m_c, g_m_c, sh_f_c, sc_f_c, g_f_c = modulation(c_ctx[None, :], ada_w[i], ada_b[i])
        sh_m_l, sc_m_l, g_m_l, sh_f_l, sc_f_l, g_f_l = modulation(c, ada_w[i], ada_b[i])
        h_ctx = adaln(x_ctx, sh_m_c, sc_m_c)
        h_lat = adaln(x_lat, sh_m_l, sc_m_l)
        if kind == 0:
            p = {'wqkv': da_wqkv[j], 'q_norm': da_q_norm[j], 'k_norm': da_k_norm[j],
                 'lam': da_lambda[j], 'subln': da_subln[j], 'wo': da_wo[j]}
            lam_init = 0.8 - 0.6 * math.exp(-0.3 * i)
            o_ctx, k_new, v_new = da_context(h_ctx, p, lam_init)
            o_lat = da_latent(h_lat, cache_da_k[:, j], cache_da_v[:, j], cos_da, sin_da, p, lam_init)
            da_k_list.append(k_new)
            da_v_list.append(v_new)
        elif kind == 1:
            p = {'mu': rwkv_mu[j], 'wrkv': rwkv_wrkv[j], 'w0': rwkv_w0[j], 'w1': rwkv_w1[j],
                 'w2': rwkv_w2[j], 'a0': rwkv_a0[j], 'a1': rwkv_a1[j], 'a2': rwkv_a2[j],
                 'g1': rwkv_g1[j], 'g2': rwkv_g2[j], 'k_k': rwkv_k_k[j], 'k_a': rwkv_k_a[j],
                 'r_k': rwkv_r_k[j], 'ln_w': rwkv_ln_w[j], 'ln_b': rwkv_ln_b[j], 'wo': rwkv_wo[j]}
            s_zero = jnp.zeros((b_ctx, 2, RWKV_HEADS, RWKV_HEAD, RWKV_HEAD), f32)
            o_ctx, s_new = rwkv_mixer(h_ctx, s_zero, p)
            o_lat, _ = rwkv_mixer(h_lat, state_rwkv[:, j], p)
            rwkv_list.append(s_new)
        else:
            p = {'wqkv': swa_wqkv[j], 'q_norm': swa_q_norm[j], 'k_norm': swa_k_norm[j],
                 'sink': swa_sink[j], 'wo': swa_wo[j]}
            o_ctx, k_new, v_new = swa_context(h_ctx, p)
            o_lat = swa_latent(h_lat, cache_swa_k[:, j], cache_swa_v[:, j], cos_swa, sin_swa, p)
            swa_k_list.append(k_new)
            swa_v_list.append(v_new)
        x_ctx = x_ctx + g_m_c * o_ctx
        x_lat = x_lat + g_m_l * o_lat
        x_ctx = x_ctx + g_f_c * squared_relu_mlp(adaln(x_ctx, sh_f_c, sc_f_c), mlp_w1[i], mlp_w2[i])
        x_lat = x_lat + g_f_l * squared_relu_mlp(adaln(x_lat, sh_f_l, sc_f_l), mlp_w1[i], mlp_w2[i])
    new_da_k = jnp.stack(da_k_list, axis=1)
    new_da_v = jnp.stack(da_v_list, axis=1)
    new_state_rwkv = jnp.stack(rwkv_list, axis=1)
    new_swa_k = jnp.stack(swa_k_list, axis=1)
    new_swa_v = jnp.stack(swa_v_list, axis=1)
    return (x_ctx, x_lat, new_da_k, new_da_v, new_state_rwkv, new_swa_k, new_swa_v)
```

```cpp
#include <hip/hip_runtime.h>
#include <hip/hip_cooperative_groups.h>
#include <cstdio>
#include <cstdint>
namespace cg = cooperative_groups;
#define DI __device__ __forceinline__
namespace pg8 {
#define PG8_LAS __attribute__((address_space(3)))
typedef unsigned short bf16_t;
typedef short bf16x8 __attribute__((ext_vector_type(8)));
typedef float f32x4 __attribute__((ext_vector_type(4)));
typedef unsigned u32x4 __attribute__((ext_vector_type(4)));
constexpr int BM = 256, BK = 64, HALF = 128, HTB = HALF * BK * 2  , STAGE_BYTES = 8 * HTB, NXCD = 8, WGM = 8;

__host__ __device__ __forceinline__ int lds_byte(int r, int c) { const int st = (r >> 4) * 2 + (c >> 5), rr = r & 15, cc = c & 31, ob = rr * 64 + cc * 2; return st * 1024 + (ob ^ (((ob >> 9) & 1) << 5)); }
__host__ __device__ __forceinline__ void stage_rc(int b, int& R, int& C) { const int st = b / 1024, sb = b % 1024, swz = sb ^ (((sb >> 9) & 1) << 5); R = (st >> 1) * 16 + swz / 64; C = (st & 1) * 32 + (swz % 64) / 2; }
__host__ __device__ __forceinline__ int perm32(int rho) { const int n = rho >> 4, i = rho & 15; return 8 * (i >> 2) + 4 * n + (i & 3); }

struct Unit { int pm, pn; };
struct Gemm { const bf16_t* A; const bf16_t* Bt; int lda, ldb, M, N, K; };

struct StaticOrder {
    int nM, nN, nwg, G, c;
    __host__ __device__ void init(int M, int N, int G_, int c_) { nM = M / BM; nN = N / BM; nwg = nM * nN; G = G_; c = c_; }
    __host__ __device__ bool next(int i, Unit& u) const {
        const long L = (long)i * G + c; if (L >= nwg) return false;
        int wgid = (int)L; { const int q = nwg / NXCD, r = nwg % NXCD, xcd = wgid % NXCD, off = wgid / NXCD; wgid = (xcd < r ? xcd * (q + 1) : r * (q + 1) + (xcd - r) * q) + off; }
        const int nig = WGM * nN, gid = wgid / nig, fm = gid * WGM, gsz = (nM - fm) < WGM ? (nM - fm) : WGM;
        u.pm = fm + ((wgid % nig) % gsz); u.pn = (wgid % nig) / gsz; return true;
    }
    __device__ __forceinline__ void a_ready(const Unit&) const {}
    __device__ __forceinline__ void done(const Unit&) const {}
};


template <class Epi, class Sched, bool ALIGN_EPI = false, bool SP2 = false>
__device__ __forceinline__ void gemm_phase(PG8_LAS unsigned char* lds, const Gemm g, const Sched& S, const Epi& E, const int tid) {
    const int wid = __builtin_amdgcn_readfirstlane(tid >> 6), lane = tid & 63, wr = wid >> 2, wc = wid & 3, fr = lane & 15, fq = lane >> 4;
    const int K = g.K, nt = K / BK;
    unsigned voffA[2], voffB[2];
#pragma unroll
    for (int i = 0; i < 2; ++i) { int R, C; stage_rc(tid * 16 + i * 8192, R, C); const int Rb = Epi::PERM ? ((R & ~31) + perm32(R & 31)) : R;
        voffA[i] = (unsigned)(R * g.lda + C) * 2u; voffB[i] = (unsigned)(Rb * g.ldb + C) * 2u; }
    const size_t kstep = (size_t)(BK * 2);
    const size_t hstepA = (size_t)HALF * g.lda * 2, hstepB = (size_t)HALF * g.ldb * 2;
    const size_t tstepA = 2 * hstepA, tstepB = 2 * hstepB;
    const unsigned ldsw = (unsigned)wid * 1024u;
    const int aoff = lds_byte(wr * 64 + fr, fq * 8), boff = lds_byte(wc * 32 + fr, fq * 8);
#define PG8_SA(b, h) (((b) * 2 + (h)) * HTB)
#define PG8_SB(b, h) ((4 + (b) * 2 + (h)) * HTB)
#define PG8_STAGE(bufoff, gbase, voff) do { _Pragma("unroll") for (int _i = 0; _i < 2; ++_i) \
        __builtin_amdgcn_global_load_lds((const unsigned*)((const char*)(gbase) + (voff)[_i]), (PG8_LAS unsigned*)(lds + (bufoff) + ldsw + _i * 8192), 16, 0, 0); } while (0)
#define PG8_LDA(dst, b, h) do { _Pragma("unroll") for (int m = 0; m < 4; ++m) _Pragma("unroll") for (int k = 0; k < 2; ++k) dst[m][k] = *(const PG8_LAS bf16x8*)(lds + PG8_SA(b, h) + aoff + m * 2048 + k * 1024); } while (0)
#define PG8_LDB(dst, b, h) do { _Pragma("unroll") for (int n = 0; n < 2; ++n) _Pragma("unroll") for (int k = 0; k < 2; ++k) dst[n][k] = *(const PG8_LAS bf16x8*)(lds + PG8_SB(b, h) + boff + n * 2048 + k * 1024); } while (0)
#define PG8_MMA(ai, bj, At, Bt) do { __builtin_amdgcn_s_setprio(1); _Pragma("unroll") for (int m = 0; m < 4; ++m) _Pragma("unroll") for (int n = 0; n < 2; ++n) _Pragma("unroll") for (int k = 0; k < 2; ++k) \
        acc[ai][bj][m][n] = __builtin_amdgcn_mfma_f32_16x16x32_bf16(Bt[n][k], At[m][k], acc[ai][bj][m][n], 0, 0, 0); __builtin_amdgcn_s_setprio(0); } while (0)
#define PG8_WAIT_V(n) asm volatile("s_waitcnt vmcnt(" #n ")" ::: "memory")
#define PG8_WAIT_L(n) asm volatile("s_waitcnt lgkmcnt(" #n ")" ::: "memory")
#define PG8_BAR __builtin_amdgcn_s_barrier()
#define PG8_SCHED __builtin_amdgcn_sched_barrier(0)
    Unit cur, nxt; int ui = 0;
    if (!S.next(0, cur)) return;
    f32x4 acc[2][2][4][2];
#pragma unroll
    for (int a = 0; a < 2; ++a)
#pragma unroll
        for (int b = 0; b < 2; ++b)
#pragma unroll
            for (int m = 0; m < 4; ++m)
#pragma unroll
                for (int n = 0; n < 2; ++n) acc[a][b][m][n] = (f32x4){0.f, 0.f, 0.f, 0.f};
    bf16x8 At[4][2], B0[2][2], B1[2][2];
    const char* cA = (const char*)g.A + (size_t)cur.pm * tstepA; const char* cB = (const char*)g.Bt + (size_t)cur.pn * tstepB;
    S.a_ready(cur);
    if constexpr (SP2) {
        PG8_STAGE(PG8_SB(0, 0), cB, voffB); PG8_STAGE(PG8_SB(0, 1), cB + hstepB, voffB); PG8_STAGE(PG8_SA(0, 0), cA, voffA); PG8_STAGE(PG8_SA(0, 1), cA + hstepA, voffA);
        if (wr == 1) PG8_BAR;
        PG8_WAIT_V(2); PG8_BAR;
        PG8_STAGE(PG8_SB(1, 0), cB + kstep, voffB); PG8_STAGE(PG8_SA(1, 0), cA + kstep, voffA); PG8_STAGE(PG8_SB(1, 1), cB + hstepB + kstep, voffB);
        PG8_WAIT_V(6); PG8_BAR;
    } else {
        PG8_STAGE(PG8_SB(0, 0), cB, voffB); PG8_STAGE(PG8_SA(0, 0), cA, voffA); PG8_STAGE(PG8_SB(0, 1), cB + hstepB, voffB); PG8_STAGE(PG8_SA(0, 1), cA + hstepA, voffA);
        if (wr == 1) PG8_BAR;
        PG8_WAIT_V(4); PG8_BAR;
        PG8_STAGE(PG8_SB(1, 0), cB + kstep, voffB); PG8_STAGE(PG8_SA(1, 0), cA + kstep, voffA); PG8_STAGE(PG8_SB(1, 1), cB + hstepB + kstep, voffB);
        PG8_WAIT_V(6); PG8_BAR;
    }
    for (;;) {
        const bool has_next = S.next(ui + 1, nxt);
        const char* nA = has_next ? (const char*)g.A + (size_t)nxt.pm * tstepA : cA; const char* nB = has_next ? (const char*)g.Bt + (size_t)nxt.pn * tstepB : cB;
        for (int t = 0; t < nt; t += 2) {
            const bool last = (t == nt - 2);
            const char* a1 = cA + (size_t)(t + 1) * kstep;
            const char* a2 = last ? nA : cA + (size_t)(t + 2) * kstep; const char* b2 = last ? nB : cB + (size_t)(t + 2) * kstep;
            const char* a3 = a2 + kstep; const char* b3 = b2 + kstep;
            if (last && has_next) S.a_ready(nxt);
            if constexpr (SP2) {
            PG8_LDB(B0, 0, 0); PG8_LDB(B1, 0, 1); PG8_SCHED; PG8_LDA(At, 0, 0); PG8_STAGE(PG8_SA(1, 1), a1 + hstepA, voffA);
            PG8_WAIT_V(8); PG8_WAIT_L(0); PG8_BAR; PG8_MMA(0, 0, At, B0); PG8_MMA(0, 1, At, B1); PG8_BAR; PG8_SCHED;
            PG8_LDA(At, 0, 1); PG8_STAGE(PG8_SB(0, 0), b2, voffB); PG8_STAGE(PG8_SB(0, 1), b2 + hstepB, voffB); PG8_STAGE(PG8_SA(0, 0), a2, voffA);
            PG8_WAIT_V(8); PG8_WAIT_L(0); PG8_BAR; PG8_MMA(1, 0, At, B0); PG8_MMA(1, 1, At, B1); PG8_BAR; PG8_SCHED;
            PG8_LDB(B0, 1, 0); PG8_LDB(B1, 1, 1); PG8_SCHED; PG8_LDA(At, 1, 0); PG8_STAGE(PG8_SA(0, 1), a2 + hstepA, voffA);
            PG8_WAIT_V(8); PG8_WAIT_L(0); PG8_BAR; PG8_MMA(0, 0, At, B0); PG8_MMA(0, 1, At, B1); PG8_BAR; PG8_SCHED;
            PG8_LDA(At, 1, 1); PG8_STAGE(PG8_SB(1, 0), b3, voffB); PG8_STAGE(PG8_SB(1, 1), b3 + hstepB, voffB); PG8_STAGE(PG8_SA(1, 0), a3, voffA);
            PG8_WAIT_V(8); PG8_WAIT_L(0); PG8_BAR; PG8_MMA(1, 0, At, B0); PG8_MMA(1, 1, At, B1); PG8_BAR; PG8_SCHED;
            } else {
            PG8_LDB(B0, 0, 0); PG8_SCHED; PG8_LDA(At, 0, 0); PG8_STAGE(PG8_SA(1, 1), a1 + hstepA, voffA);
            PG8_WAIT_L(8); PG8_BAR; PG8_WAIT_L(0); PG8_MMA(0, 0, At, B0); PG8_BAR; PG8_SCHED;
            PG8_LDB(B1, 0, 1); PG8_STAGE(PG8_SB(0, 0), b2, voffB);
            PG8_BAR; PG8_WAIT_L(0); PG8_MMA(0, 1, At, B1); PG8_BAR;
            PG8_LDA(At, 0, 1); PG8_STAGE(PG8_SA(0, 0), a2, voffA);
            PG8_BAR; PG8_WAIT_L(0); PG8_MMA(1, 0, At, B0); PG8_BAR; PG8_SCHED;
            PG8_STAGE(PG8_SB(0, 1), b2 + hstepB, voffB);
            PG8_WAIT_V(6); PG8_BAR; PG8_MMA(1, 1, At, B1); PG8_BAR;
            PG8_LDB(B0, 1, 0); PG8_SCHED; PG8_LDA(At, 1, 0); PG8_STAGE(PG8_SA(0, 1), a2 + hstepA, voffA);
            PG8_WAIT_L(8); PG8_BAR; PG8_WAIT_L(0); PG8_MMA(0, 0, At, B0); PG8_BAR; PG8_SCHED;
            PG8_LDB(B1, 1, 1); PG8_STAGE(PG8_SB(1, 0), b3, voffB);
            PG8_BAR; PG8_WAIT_L(0); PG8_MMA(0, 1, At, B1); PG8_BAR;
            PG8_LDA(At, 1, 1); PG8_STAGE(PG8_SA(1, 0), a3, voffA);
            PG8_BAR; PG8_WAIT_L(0); PG8_MMA(1, 0, At, B0); PG8_BAR; PG8_SCHED;
            PG8_STAGE(PG8_SB(1, 1), b3 + hstepB, voffB);
            PG8_WAIT_V(6); PG8_BAR; PG8_MMA(1, 1, At, B1); PG8_BAR;
            }
        }
        if constexpr (ALIGN_EPI) { if (wr == 0) PG8_BAR; }
        if constexpr (!Epi::AFTER_DRAIN) { E(acc, cur, wr, wc, fr, fq); S.done(cur); }
        if (!has_next) break;
#pragma unroll
        for (int a = 0; a < 2; ++a)
#pragma unroll
            for (int b = 0; b < 2; ++b)
#pragma unroll
                for (int m = 0; m < 4; ++m)
#pragma unroll
                    for (int n = 0; n < 2; ++n) acc[a][b][m][n] = (f32x4){0.f, 0.f, 0.f, 0.f};
        cur = nxt; cA = nA; cB = nB; ++ui;
        if constexpr (ALIGN_EPI) { if (wr == 1) PG8_BAR; }
    }
    PG8_WAIT_V(0);
    if constexpr (!ALIGN_EPI) { if (wr == 0) PG8_BAR; }
    PG8_BAR;
    if constexpr (Epi::AFTER_DRAIN) { E.fused(acc, cur, wr, wc, fr, fq, lds, wid, lane); S.done(cur); }
#undef PG8_SA
#undef PG8_SB
#undef PG8_STAGE
#undef PG8_LDA
#undef PG8_LDB
#undef PG8_MMA
#undef PG8_WAIT_V
#undef PG8_WAIT_L
#undef PG8_BAR
#undef PG8_SCHED
}
}


#define LAS __attribute__((address_space(3)))
typedef unsigned short bf16_t;
typedef short bf16x8 __attribute__((ext_vector_type(8)));
typedef float f32x4 __attribute__((ext_vector_type(4)));
typedef float f32x2 __attribute__((ext_vector_type(2)));
typedef float f32x16 __attribute__((ext_vector_type(16)));
typedef unsigned u32x4 __attribute__((ext_vector_type(4)));
typedef unsigned u32x2 __attribute__((ext_vector_type(2)));
typedef __bf16 bf16x2_t __attribute__((ext_vector_type(2)));

constexpr int D = 1024, FFD = 4096, M_CTX = 8192, M_LAT = 4096, M_ALL = 12288, T_CTX = 256, T_LAT = 2048, NPAST = 256;
constexpr int MODW = 6144;
constexpr size_t MiB = 1u << 20;
constexpr size_t O_X = 0, O_DAK = 12582912, O_DAV = 29360128, O_RW = 46137344, O_SWK = 50331648, O_SWV = 52428800;
constexpr size_t WS_MOD = 0;
constexpr size_t WS_ROPE = 512 * 1024;
constexpr size_t WS_SEGF = 1 * MiB;
constexpr size_t WS_W = 33 * MiB;
constexpr size_t WS_A = 53 * MiB;
constexpr size_t WS_B = 101 * MiB;
constexpr size_t WS_C = 197 * MiB;
constexpr size_t WS_END = 341 * MiB;
constexpr size_t WS_W1T = WS_A + 24 * MiB, WS_W2T = WS_A + 32 * MiB;
constexpr size_t WS_QKV = WS_B, WS_AO = WS_B + 72 * MiB;
constexpr size_t WS_LORA = WS_B + 72 * MiB;
constexpr size_t WS_RG = WS_A, WS_RAO = WS_A + 24 * MiB, WS_TS = WS_A + 24 * MiB;
constexpr size_t WS_E = WS_C, WS_AA = WS_C + 48 * MiB, WS_Y = WS_C + 96 * MiB;
constexpr size_t WS_VTC = WS_C, WS_VTL = WS_C + 32 * MiB, WS_KC = WS_C + 48 * MiB;
constexpr size_t WS_S1T = WS_W;
constexpr size_t WS_S2T = WS_W + 14 * MiB;
constexpr size_t WS_G2T = WS_W + 16 * MiB;
constexpr size_t WS_RWO = WS_W + 17 * MiB;
constexpr size_t WS_WQKVT = WS_W, WS_WOT = WS_W + 8 * MiB;

constexpr float LOG2E = 1.4426950408889634f;
constexpr float QSCALE = 0.125f * LOG2E;

struct Params { const float* in[40]; float* out; unsigned char* ws; int ph_lo, ph_hi; };
typedef const __attribute__((address_space(4))) Params* KP;

DI unsigned cvtpk(float lo, float hi) { f32x2 v = {lo, hi}; bf16x2_t b = __builtin_convertvector(v, bf16x2_t); return __builtin_bit_cast(unsigned, b); }
DI float bflo(unsigned w) { return __uint_as_float(w << 16); }
DI float bfhi(unsigned w) { return __uint_as_float(w & 0xffff0000u); }
DI float bf2f(bf16_t b) { return __uint_as_float(((unsigned)b) << 16); }
DI void unpack8(const u32x4 w, float (&f)[8]) { f[0] = bflo(w.x); f[1] = bfhi(w.x); f[2] = bflo(w.y); f[3] = bfhi(w.y); f[4] = bflo(w.z); f[5] = bfhi(w.z); f[6] = bflo(w.w); f[7] = bfhi(w.w); }
DI u32x4 pack8(const float (&f)[8]) { u32x4 w; w.x = cvtpk(f[0], f[1]); w.y = cvtpk(f[2], f[3]); w.z = cvtpk(f[4], f[5]); w.w = cvtpk(f[6], f[7]); return w; }
template <int CTRL> DI float dpp_mov(float v) { return __uint_as_float((unsigned)__builtin_amdgcn_update_dpp(0, (int)__float_as_uint(v), CTRL, 0xF, 0xF, true)); }
DI float sum2(float v) { v += dpp_mov<0xB1>(v); return v; }
DI float sum8(float v) { v += dpp_mov<0xB1>(v); v += dpp_mov<0x4E>(v); v += dpp_mov<0x141>(v); return v; }
DI float wave_sum(float v) {
#pragma unroll
    for (int o = 1; o < 64; o <<= 1) v += __shfl_xor(v, o);
    return v;
}
DI float sigmoidf_(float x) { return 1.f / (1.f + __expf(-x)); }
DI int cond_of_row(int row) { return row < M_CTX ? 0 : (row < M_CTX + T_LAT ? 1 : 2); }

struct EpiAct {
    static constexpr bool PERM = true, AFTER_DRAIN = false;
    bf16_t* O; int ldc; int mode; bf16_t* O2; int ldc2; const float* b0; const float* b1;
    DI void operator()(const pg8::f32x4 (&acc)[2][2][4][2], const pg8::Unit& u, int wr, int wc, int fr, int fq) const {
        const int row0 = u.pm * 256 + wr * 64 + fr;
        bf16_t* base = O; int ld = ldc; int colt = u.pn * 256; int act0 = 0, act1 = 0; const float* bias = nullptr; float cmul = 1.f;
        if (mode == 1) { act0 = act1 = 1; }
        else if (mode == 2) { if (u.pn >= 12) { base = O2; ld = ldc2; colt = (u.pn - 12) * 256; act0 = (u.pn == 12) ? 2 : 3; act1 = 0; } }
        else if (mode == 3) { act0 = act1 = 4; if (u.pn < 8) { bias = b0 + u.pn * 256; cmul = 0.6065306597126334f; base = O + (size_t)(u.pn >> 2) * M_ALL * D; colt = (u.pn & 3) * 256; }
                              else { bias = b1 + (u.pn - 8) * 256; base = O2 + (size_t)((u.pn - 8) >> 2) * M_ALL * D; colt = (u.pn & 3) * 256; ld = ldc2; } }
        const int cw = wc * 32 + 8 * fq;
#pragma unroll
        for (int ai = 0; ai < 2; ++ai)
#pragma unroll
            for (int m = 0; m < 4; ++m) {
                bf16_t* rowp = base + (size_t)(row0 + ai * 128 + m * 16) * ld + colt + cw;
#pragma unroll
                for (int bj = 0; bj < 2; ++bj) {
                    const int act = bj ? act1 : act0;
                    float v[8];
#pragma unroll
                    for (int j = 0; j < 4; ++j) { v[j] = acc[ai][bj][m][0][j]; v[4 + j] = acc[ai][bj][m][1][j]; }
                    if (act == 1) {
#pragma unroll
                        for (int j = 0; j < 8; ++j) { const float r = fmaxf(v[j], 0.f); v[j] = r * r; }
                    } else if (act == 2) {
#pragma unroll
                        for (int j = 0; j < 8; ++j) { const float e2 = __expf(2.f * v[j]); v[j] = 1.f - 2.f / (e2 + 1.f); }
                    } else if (act == 3) {
#pragma unroll
                        for (int j = 0; j < 8; ++j) v[j] = sigmoidf_(v[j]);
                    } else if (act == 4) {
                        const float* bp = bias + bj * 128 + cw;
#pragma unroll
                        for (int j = 0; j < 8; ++j) v[j] = cmul * sigmoidf_(v[j] + bp[j]);
                    }
                    *(u32x4*)(rowp + bj * 128) = pack8(v);
                }
            }
    }
};
struct EpiRes {
    static constexpr bool PERM = false, AFTER_DRAIN = false;
    float* X; const float* gate3;
    DI void operator()(const pg8::f32x4 (&acc)[2][2][4][2], const pg8::Unit& u, int wr, int wc, int fr, int fq) const {
        const int cond = u.pm < 32 ? 0 : (u.pm < 40 ? 1 : 2);
        const float* g = gate3 + cond * MODW;
        const int col0 = u.pn * 256 + wc * 32 + 4 * fq, row0 = u.pm * 256 + wr * 64 + fr;
#pragma unroll
        for (int bj = 0; bj < 2; ++bj)
#pragma unroll
            for (int n = 0; n < 2; ++n) {
                const int col = col0 + bj * 128 + n * 16;
                const f32x4 gv = *(const f32x4*)(g + col);
#pragma unroll
                for (int ai = 0; ai < 2; ++ai)
#pragma unroll
                    for (int m = 0; m < 4; ++m) {
                        float* p = X + (size_t)(row0 + ai * 128 + m * 16) * D + col;
                        f32x4 v = *(const f32x4*)p; v += gv * acc[ai][bj][m][n]; *(f32x4*)p = v;
                    }
            }
    }
};

template <class Epi> DI void run_gemm(LAS unsigned char* lds, const bf16_t* A, int lda, const bf16_t* Bt, int ldb, int N, int K, const Epi& E, int tid) {
    pg8::Gemm g{A, Bt, lda, ldb, M_ALL, N, K}; pg8::StaticOrder S; S.init(M_ALL, N, (int)gridDim.x, (int)blockIdx.x);
    pg8::gemm_phase<Epi, pg8::StaticOrder, true, true>(lds, g, S, E, tid);
}

DI void titem(const float* W, int N, bf16_t* dst, int ldt, int nrow0, int kcol0, const float* ks, int kb, int nb, LAS float* scr, int lane) {
    const int k0 = 64 * kb, n0 = 32 * nb;
    const int c = lane & 7;
    if (W) {
#pragma unroll 8
        for (int i = 0; i < 32; ++i) { const int kk = 2 * i + (lane >> 5); float w = W[(size_t)(k0 + kk) * N + n0 + (lane & 31)]; if (ks) w *= ks[k0 + kk]; scr[kk * 33 + (lane & 31)] = w; }
        asm volatile("s_waitcnt lgkmcnt(0)" ::: "memory");
#pragma unroll
        for (int j = 0; j < 4; ++j) { const int n = (lane >> 3) + 8 * j; const LAS float* s = scr + (8 * c) * 33 + n;
            u32x4 o; o.x = cvtpk(s[0 * 33], s[1 * 33]); o.y = cvtpk(s[2 * 33], s[3 * 33]); o.z = cvtpk(s[4 * 33], s[5 * 33]); o.w = cvtpk(s[6 * 33], s[7 * 33]);
            *(u32x4*)(dst + (size_t)(nrow0 + n0 + n) * ldt + kcol0 + k0 + 8 * c) = o; }
        asm volatile("s_waitcnt lgkmcnt(0)" ::: "memory");
    } else {
#pragma unroll
        for (int j = 0; j < 4; ++j) { const int n = (lane >> 3) + 8 * j; *(u32x4*)(dst + (size_t)(nrow0 + n0 + n) * ldt + kcol0 + k0 + 8 * c) = (u32x4){0u, 0u, 0u, 0u}; }
    }
}
struct WaveCtx { int gw, ngw, lane; LAS float* scr; };
DI void tmat(const WaveCtx& w, int& itbase, const float* W, int K, int N, bf16_t* dst, int ldt, int nrow0, int kcol0, const float* ks) {
    const int nblk = N / 32, nit = (K / 64) * nblk;
    int first = (w.gw - itbase % w.ngw + w.ngw) % w.ngw;
    for (int it = first; it < nit; it += w.ngw) titem(W, N, dst, ldt, nrow0, kcol0, ks, it / nblk, it % nblk, w.scr, w.lane);
    itbase += nit;
}
DI void tzero(const WaveCtx& w, int& itbase, int K, int N, bf16_t* dst, int ldt, int nrow0, int kcol0) {
    const int nblk = N / 32, nit = (K / 64) * nblk;
    int first = (w.gw - itbase % w.ngw + w.ngw) % w.ngw;
    for (int it = first; it < nit; it += w.ngw) titem(nullptr, N, dst, ldt, nrow0, kcol0, nullptr, it / nblk, it % nblk, w.scr, w.lane);
    itbase += nit;
}

DI void convert_mixer_weights(KP p, const WaveCtx& w, int layer) {
    const int kind = layer % 3, j = layer / 3; unsigned char* ws = p->ws; int ib = 0;
    if (kind == 0) {
        tmat(w, ib, p->in[13] + (size_t)j * D * 3072, D, 3072, (bf16_t*)(ws + WS_WQKVT), D, 0, 0, nullptr);
        tmat(w, ib, p->in[18] + (size_t)j * D * D, D, D, (bf16_t*)(ws + WS_WOT), D, 0, 0, nullptr);
    } else if (kind == 2) {
        tmat(w, ib, p->in[35], D, 1536, (bf16_t*)(ws + WS_WQKVT), D, 0, 0, nullptr);
        tmat(w, ib, p->in[39], D, D, (bf16_t*)(ws + WS_WOT), D, 0, 0, nullptr);
    } else {
        bf16_t* s1 = (bf16_t*)(ws + WS_S1T); const float* mu = p->in[19];
        for (int m = 0; m < 3; ++m) {
            tmat(w, ib, p->in[20] + (size_t)m * D * D, D, D, s1, 2048, m * 1024, 0, nullptr);
            tmat(w, ib, p->in[20] + (size_t)m * D * D, D, D, s1, 2048, m * 1024, 1024, mu + m * D);
        }
        for (int d = 0; d < 2; ++d) {
            tmat(w, ib, p->in[22] + (size_t)d * D * 64, D, 64, s1, 2048, 3072 + d * 64, 0, nullptr);
            tmat(w, ib, p->in[22] + (size_t)d * D * 64, D, 64, s1, 2048, 3072 + d * 64, 1024, mu + 3 * D);
            tmat(w, ib, p->in[25] + (size_t)d * D * 64, D, 64, s1, 2048, 3200 + d * 64, 0, nullptr);
            tmat(w, ib, p->in[25] + (size_t)d * D * 64, D, 64, s1, 2048, 3200 + d * 64, 1024, mu + 4 * D);
        }
        tmat(w, ib, p->in[27], D, 128, s1, 2048, 3328, 0, nullptr);
        tmat(w, ib, p->in[27], D, 128, s1, 2048, 3328, 1024, mu + 5 * D);
        tzero(w, ib, 2048, 128, s1, 2048, 3456, 0);
        bf16_t* s2 = (bf16_t*)(ws + WS_S2T);
        for (int rg = 0; rg < 4; ++rg)
            for (int kb = 0; kb < 4; ++kb) {
                if (kb == rg) tmat(w, ib, (rg < 2 ? p->in[23] : p->in[26]) + (size_t)(rg & 1) * 64 * D, 64, D, s2, 256, rg * 1024, kb * 64, nullptr);
                else tzero(w, ib, 64, D, s2, 256, rg * 1024, kb * 64);
            }
        bf16_t* g2 = (bf16_t*)(ws + WS_G2T);
        tmat(w, ib, p->in[28], 128, D, g2, 256, 0, 0, nullptr);
        tzero(w, ib, 128, D, g2, 256, 0, 128);
        tmat(w, ib, p->in[34], D, D, (bf16_t*)(ws + WS_RWO), D, 0, 0, nullptr);
    }
}
DI void convert_mlp_weights(KP p, const WaveCtx& w, int layer) {
    int ib = 0;
    tmat(w, ib, p->in[11] + (size_t)layer * D * FFD, D, FFD, (bf16_t*)(p->ws + WS_W1T), D, 0, 0, nullptr);
    tmat(w, ib, p->in[12] + (size_t)layer * D * FFD, FFD, D, (bf16_t*)(p->ws + WS_W2T), FFD, 0, 0, nullptr);
}

DI void phase_mod(KP p, LAS unsigned char* lds, const int tid) {
    LAS float* sl = (LAS float*)lds;
    LAS float* red = sl + 3 * 1024;
    for (int i = tid; i < 3 * 1024; i += 512) { const int c = i >> 10, k = i & 1023; const float v = (c == 0) ? p->in[8][k] : p->in[7][(c - 1) * 1024 + k]; sl[i] = v / (1.f + __expf(-v)); }
    __syncthreads();
    float* mod = (float*)(p->ws + WS_MOD);
    const int cg_ = tid & 63, kg = tid >> 6;
    for (int unit = blockIdx.x; unit < 4 * 96; unit += gridDim.x) {
        const int l = unit / 96, c0 = (unit % 96) * 64;
        const float* W = p->in[9] + (size_t)l * D * MODW + c0 + cg_;
        float a0 = 0.f, a1 = 0.f, a2 = 0.f;
#pragma unroll 8
        for (int k = kg * 128; k < kg * 128 + 128; ++k) { const float wv = W[(size_t)k * MODW]; a0 += sl[k] * wv; a1 += sl[1024 + k] * wv; a2 += sl[2048 + k] * wv; }
        red[(kg * 3 + 0) * 64 + cg_] = a0; red[(kg * 3 + 1) * 64 + cg_] = a1; red[(kg * 3 + 2) * 64 + cg_] = a2;
        __syncthreads();
        if (tid < 192) { const int c = tid >> 6; float s = p->in[10][l * MODW + c0 + cg_];
#pragma unroll
            for (int q = 0; q < 8; ++q) s += red[(q * 3 + c) * 64 + cg_];
            mod[(size_t)(l * 3 + c) * MODW + c0 + cg_] = s; }
        __syncthreads();
    }
    float* rc = (float*)(p->ws + WS_ROPE); float* rs = rc + 2048 * 32;
    for (int i = blockIdx.x * 512 + tid; i < 2048 * 32; i += gridDim.x * 512) {
        const int t = i >> 5, jj = i & 31; const int pos = (jj < 16) ? (t >> 6) : (t & 63); const int f = jj & 15;
        const float inv = __builtin_amdgcn_exp2f(-(float)f * (13.287712379549449f / 16.f)); const float ang = (float)pos * inv;
        const float kq = rintf(ang * 0.15915494309189535f); float rr = fmaf(-kq, 6.2831855f, ang); rr = fmaf(-kq, -1.7484555e-7f, rr);
        rc[i] = __cosf(rr); rs[i] = __sinf(rr);
    }
}

DI void norm_row(const float* xr, const float* sc, const float* sh, int lane, f32x4 (&h)[4], bool valid) {
    const f32x4* x4 = (const f32x4*)xr + lane; float ss = 0.f;
#pragma unroll
    for (int j = 0; j < 4; ++j) { h[j] = valid ? x4[64 * j] : (f32x4){0.f, 0.f, 0.f, 0.f}; ss += (h[j].x * h[j].x + h[j].y * h[j].y) + (h[j].z * h[j].z + h[j].w * h[j].w); }
    const float rstd = rsqrtf(wave_sum(ss) * (1.f / D) + 1e-6f);
    const f32x4* sc4 = (const f32x4*)sc + lane; const f32x4* sh4 = (const f32x4*)sh + lane;
#pragma unroll
    for (int j = 0; j < 4; ++j) { const f32x4 s = sc4[64 * j], b = sh4[64 * j]; h[j] = valid ? (h[j] * rstd * (1.f + s) + b) : (f32x4){0.f, 0.f, 0.f, 0.f}; }
}
DI const float* xrow_ptr(KP p, int row, bool from_input) {
    if (from_input) return row < M_CTX ? p->in[0] + (size_t)row * D : p->in[1] + (size_t)(row - M_CTX) * D;
    return p->out + O_X + (size_t)row * D;
}
DI void phase_norm(KP p, const WaveCtx& w, int layer, int which) {
    const float* mod = (const float*)(p->ws + WS_MOD) + (size_t)layer * 3 * MODW;
    bf16_t* H = (bf16_t*)(p->ws + WS_A);
    const bool from_in = (layer == 0 && which == 0);
    for (int row = w.gw; row < M_ALL; row += w.ngw) {
        const float* mc = mod + cond_of_row(row) * MODW + which * 3 * D;
        const float* xr = xrow_ptr(p, row, from_in);
        f32x4 h[4];
        if (from_in) { const f32x4* x4 = (const f32x4*)xr + w.lane; f32x4* o4 = (f32x4*)(p->out + O_X + (size_t)row * D) + w.lane;
#pragma unroll
            for (int j = 0; j < 4; ++j) o4[64 * j] = x4[64 * j]; }
        norm_row(xr, mc + D, mc, w.lane, h, true);
        u32x2* o = (u32x2*)(H + (size_t)row * D) + w.lane;
#pragma unroll
        for (int j = 0; j < 4; ++j) { u32x2 v; v.x = cvtpk(h[j].x, h[j].y); v.y = cvtpk(h[j].z, h[j].w); o[64 * j] = v; }
    }
}
DI void phase_norm_rwkv(KP p, const WaveCtx& w, int layer) {
    const float* mod = (const float*)(p->ws + WS_MOD) + (size_t)layer * 3 * MODW;
    bf16_t* A2 = (bf16_t*)(p->ws + WS_A);
    for (int row = w.gw; row < M_ALL; row += w.ngw) {
        const float* mc = mod + cond_of_row(row) * MODW;
        int t, T; if (row < M_CTX) { t = row & 255; T = T_CTX; } else { t = (row - M_CTX) & 2047; T = T_LAT; }
        const float* xr = p->out + O_X + (size_t)row * D;
        f32x4 hc[4], hp[4], hn[4];
        norm_row(xr, mc + D, mc, w.lane, hc, true);
        norm_row(xr - D, mc + D, mc, w.lane, hp, t > 0);
        norm_row(t < T - 1 ? xr + D : xr, mc + D, mc, w.lane, hn, t < T - 1);
        u32x2* o = (u32x2*)(A2 + (size_t)row * 2048) + w.lane;
#pragma unroll
        for (int j = 0; j < 4; ++j) {
            u32x2 v; v.x = cvtpk(hc[j].x, hc[j].y); v.y = cvtpk(hc[j].z, hc[j].w); o[64 * j] = v;
            const f32x4 xx = 0.5f * (hp[j] + hn[j]) - hc[j];
            u32x2 q; q.x = cvtpk(xx.x, xx.y); q.y = cvtpk(xx.z, xx.w); o[256 + 64 * j] = q;
        }
    }
}

struct AttnCfg {
    int ldq;
    int nq, nk;
    int vw;
    int dv, nvh;
    int kl, j;
    const float *qn, *kn;
    float *kout, *vout;
    const float *ck, *cv;
};
DI AttnCfg make_cfg(KP p, int kind, int j) {
    AttnCfg c;
    if (kind == 0) { c.ldq = 3072; c.nq = 16; c.nk = 16; c.vw = 1024; c.dv = 128; c.nvh = 8; c.kl = 2; c.j = j; c.qn = p->in[14] + j * 64; c.kn = p->in[15] + j * 64;
        c.kout = p->out + O_DAK; c.vout = p->out + O_DAV; c.ck = p->in[2]; c.cv = p->in[3]; }
    else { c.ldq = 1536; c.nq = 16; c.nk = 4; c.vw = 256; c.dv = 64; c.nvh = 4; c.kl = 1; c.j = 0; c.qn = p->in[36]; c.kn = p->in[37];
        c.kout = p->out + O_SWK; c.vout = p->out + O_SWV; c.ck = p->in[5]; c.cv = p->in[6]; }
    return c;
}

DI void phase_qkprep(KP p, const WaveCtx& w, const AttnCfg& c, LAS unsigned char* lds_wave) {
    bf16_t* QKV = (bf16_t*)(p->ws + WS_QKV);
    const float* rc = (const float*)(p->ws + WS_ROPE); const float* rs = rc + 2048 * 32;
    const int lane = w.lane, g = lane >> 1, half = lane & 1;
    const int ng = c.nq + c.nk;
    for (int row = w.gw; row < M_ALL; row += w.ngw) {
        const bool lat = row >= M_CTX; const int tl = lat ? ((row - M_CTX) & 2047) : 0;
        const int b = row >> 8, t = row & 255;
        if (g < ng) {
            const bool isq = g < c.nq;
            const int col = (isq ? g * 64 : 1024 + (g - c.nq) * 64) + half * 32;
            bf16_t* src = QKV + (size_t)row * c.ldq + col;
            float v[32]; float ss = 0.f;
#pragma unroll
            for (int q4 = 0; q4 < 4; ++q4) { const u32x4 wv = *(const u32x4*)(src + 8 * q4); float f[8]; unpack8(wv, f);
#pragma unroll
                for (int e = 0; e < 8; ++e) { v[8 * q4 + e] = f[e]; ss += f[e] * f[e]; } }
            ss = sum2(ss);
            const float rstd = rsqrtf(ss * (1.f / 64.f) + 1e-6f);
            const float* gn = (isq ? c.qn : c.kn) + half * 32;
#pragma unroll
            for (int e = 0; e < 32; ++e) v[e] = v[e] * rstd * gn[e];
            if (lat) {
                const float* cp = rc + tl * 32; const float* sp = rs + tl * 32;
#pragma unroll
                for (int e = 0; e < 32; ++e) { const float pr = dpp_mov<0xB1>(v[e]); const float cs = cp[e], sn = sp[e]; v[e] = half ? (v[e] * cs + pr * sn) : (v[e] * cs - pr * sn); }
            }
            if (!isq && !lat) {
                float* ko = c.kout + ((size_t)(b * c.kl + c.j) * 256 + t) * (c.nk * 64) + (g - c.nq) * 64 + half * 32;
#pragma unroll
                for (int q4 = 0; q4 < 8; ++q4) *(f32x4*)(ko + 4 * q4) = (f32x4){v[4 * q4], v[4 * q4 + 1], v[4 * q4 + 2], v[4 * q4 + 3]};
            }
            const float qs = isq ? QSCALE : 1.f;
#pragma unroll
            for (int q4 = 0; q4 < 4; ++q4) { float f[8];
#pragma unroll
                for (int e = 0; e < 8; ++e) f[e] = v[8 * q4 + e] * qs;
                *(u32x4*)(src + 8 * q4) = pack8(f); }
        }
        if (!lat) {
            const bf16_t* vs = QKV + (size_t)row * c.ldq + 1024 + c.nk * 64;
            float* vo = c.vout + ((size_t)(b * c.kl + c.j) * 256 + t) * c.vw;
            for (int i = lane * 4; i < c.vw; i += 256) { const u32x2 wv = *(const u32x2*)(vs + i); *(f32x4*)(vo + i) = (f32x4){bflo(wv.x), bfhi(wv.x), bflo(wv.y), bfhi(wv.y)}; }
        }
    }
    {
        const int kw = c.nk * 64; bf16_t* Kc = (bf16_t*)(p->ws + WS_KC);
        const int n8 = 2 * 256 * kw / 8;
        for (int i = w.gw * 64 + lane; i < n8; i += w.ngw * 64) {
            const int r = (i * 8) / kw, cc = (i * 8) % kw; const int b = r >> 8, t = r & 255;
            const float* s = c.ck + ((size_t)(b * c.kl + c.j) * 256 + t) * kw + cc;
            const f32x4 a = *(const f32x4*)s, bq = *(const f32x4*)(s + 4);
            u32x4 o; o.x = cvtpk(a.x, a.y); o.y = cvtpk(a.z, a.w); o.z = cvtpk(bq.x, bq.y); o.w = cvtpk(bq.z, bq.w);
            *(u32x4*)(Kc + (size_t)r * kw + cc) = o;
        }
    }
    {
        LAS bf16_t* T = (LAS bf16_t*)lds_wave; const int pitch = c.dv + 2;
        bf16_t* VtC = (bf16_t*)(p->ws + WS_VTC); bf16_t* VtL = (bf16_t*)(p->ws + WS_VTL);
        const int n_ctx = 32 * 8 * c.nvh, n_lat = 2 * 64 * c.nvh, n_cache = 2 * 8 * c.nvh, ntile = n_ctx + n_lat + n_cache;
        const int cpr = c.dv / 8;
        for (int tile = w.gw; tile < ntile; tile += w.ngw) {
            int vh, blk, seq, kindt; int r = tile;
            if (r < n_ctx) { kindt = 0; vh = r % c.nvh; r /= c.nvh; blk = r % 8; seq = r / 8; }
            else if (r < n_ctx + n_lat) { r -= n_ctx; kindt = 1; vh = r % c.nvh; r /= c.nvh; blk = r % 64; seq = r / 64; }
            else { r -= n_ctx + n_lat; kindt = 2; vh = r % c.nvh; r /= c.nvh; blk = r % 8; seq = r / 8; }
            for (int ch = lane; ch < 32 * cpr; ch += 64) {
                const int tr = ch / cpr, cc = (ch % cpr) * 8; u32x4 wv;
                if (kindt == 2) { const float* s = c.cv + ((size_t)(seq * c.kl + c.j) * 256 + blk * 32 + tr) * c.vw + vh * c.dv + cc;
                    const f32x4 a = *(const f32x4*)s, bq = *(const f32x4*)(s + 4); wv.x = cvtpk(a.x, a.y); wv.y = cvtpk(a.z, a.w); wv.z = cvtpk(bq.x, bq.y); wv.w = cvtpk(bq.z, bq.w); }
                else { const int row = (kindt == 0 ? seq * 256 : M_CTX + seq * 2048) + blk * 32 + tr;
                    wv = *(const u32x4*)(QKV + (size_t)row * c.ldq + 1024 + c.nk * 64 + vh * c.dv + cc); }
                LAS unsigned* d = (LAS unsigned*)(T + tr * pitch + cc);
                d[0] = wv.x; d[1] = wv.y; d[2] = wv.z; d[3] = wv.w;
            }
            asm volatile("s_waitcnt lgkmcnt(0)" ::: "memory");
            bf16_t* dst; int ldv;
            if (kindt == 0) { dst = VtC + (size_t)((seq * c.nvh + vh) * c.dv) * 256 + blk * 32; ldv = 256; }
            else { dst = VtL + (size_t)((seq * c.nvh + vh) * c.dv) * 2304 + (kindt == 1 ? 256 : 0) + blk * 32; ldv = 2304; }
            for (int id = lane; id < c.dv * 4; id += 64) {
                const int d = id >> 2, cch = id & 3, sl = cch >> 1, hi = cch & 1;
                unsigned short e[8];
#pragma unroll
                for (int q = 0; q < 8; ++q) { const int kv = 16 * sl + 8 * (q >> 2) + 4 * hi + (q & 3); e[q] = T[kv * pitch + d]; }
                u32x4 o; o.x = e[0] | ((unsigned)e[1] << 16); o.y = e[2] | ((unsigned)e[3] << 16); o.z = e[4] | ((unsigned)e[5] << 16); o.w = e[6] | ((unsigned)e[7] << 16);
                *(u32x4*)(dst + (size_t)d * ldv + cch * 8) = o;
            }
            asm volatile("s_waitcnt lgkmcnt(0)" ::: "memory");
        }
    }
}

#define MFMA32(a, b, c) __builtin_amdgcn_mfma_f32_32x32x16_bf16((a), (b), (c), 0, 0, 0)
DI int crow(int r, int hi) { return (r & 3) + 8 * (r >> 2) + 4 * hi; }

template <int NDT, bool MASK>
DI void attn_seg(f32x16 (&o)[NDT], float& m, float& l, const bf16x8 (&qr)[4], const bf16_t* K, int ldk, const bf16_t* Vt, int ldv, int ntiles, int r32, int hi, int qpos, int kpos0) {
    for (int t = 0; t < ntiles; ++t) {
        const bf16_t* kp = K + (size_t)(t * 32 + r32) * ldk + 8 * hi;
        bf16x8 kf[4];
#pragma unroll
        for (int d0 = 0; d0 < 4; ++d0) kf[d0] = *(const bf16x8*)(kp + 16 * d0);
        f32x16 pr;
#pragma unroll
        for (int r = 0; r < 16; ++r) pr[r] = 0.f;
#pragma unroll
        for (int d0 = 0; d0 < 4; ++d0) pr = MFMA32(kf[d0], qr[d0], pr);
        if (MASK) {
#pragma unroll
            for (int r = 0; r < 16; ++r) { const int dl = kpos0 + t * 32 + crow(r, hi) - qpos; if (dl > 128 || dl < -128) pr[r] = -1e30f; }
        }
        float mx = pr[0];
#pragma unroll
        for (int r = 1; r < 16; ++r) mx = fmaxf(mx, pr[r]);
        mx = fmaxf(mx, __shfl_xor(mx, 32));
        const float mn = fmaxf(m, mx);
        const float alpha = __builtin_amdgcn_exp2f(m - mn);
        m = mn;
        float rsum = 0.f;
#pragma unroll
        for (int r = 0; r < 16; ++r) { pr[r] = __builtin_amdgcn_exp2f(pr[r] - mn); rsum += pr[r]; }
        l = l * alpha + rsum;
#pragma unroll
        for (int dt = 0; dt < NDT; ++dt)
#pragma unroll
            for (int r = 0; r < 16; ++r) o[dt][r] *= alpha;
        bf16x8 pb[2];
#pragma unroll
        for (int s = 0; s < 2; ++s) { u32x4 wv; wv.x = cvtpk(pr[8 * s], pr[8 * s + 1]); wv.y = cvtpk(pr[8 * s + 2], pr[8 * s + 3]); wv.z = cvtpk(pr[8 * s + 4], pr[8 * s + 5]); wv.w = cvtpk(pr[8 * s + 6], pr[8 * s + 7]); pb[s] = __builtin_bit_cast(bf16x8, wv); }
#pragma unroll
        for (int dt = 0; dt < NDT; ++dt) {
            const bf16_t* vp = Vt + (size_t)(dt * 32 + r32) * ldv + t * 32 + hi * 8;
            const bf16x8 v0 = *(const bf16x8*)(vp), v1 = *(const bf16x8*)(vp + 16);
            o[dt] = MFMA32(v0, pb[0], o[dt]); o[dt] = MFMA32(v1, pb[1], o[dt]);
        }
    }
}
DI void load_q(bf16x8 (&qr)[4], const bf16_t* Q, int ldq, int r32, int hi) {
#pragma unroll
    for (int d0 = 0; d0 < 4; ++d0) qr[d0] = *(const bf16x8*)(Q + (size_t)r32 * ldq + 16 * d0 + 8 * hi);
}
template <int NDT> DI void zero_o(f32x16 (&o)[NDT]) {
#pragma unroll
    for (int dt = 0; dt < NDT; ++dt)
#pragma unroll
        for (int r = 0; r < 16; ++r) o[dt][r] = 0.f;
}

DI void da_unit(KP p, int layer, bool is_lat, int b, int h, int qb, int lane, float lam, float lam_init, LAS float* osm) {
    const int j = layer / 3;
    const bf16_t* QKV = (const bf16_t*)(p->ws + WS_QKV); const bf16_t* Kc = (const bf16_t*)(p->ws + WS_KC);
    const bf16_t* VtC = (const bf16_t*)(p->ws + WS_VTC); const bf16_t* VtL = (const bf16_t*)(p->ws + WS_VTL);
    bf16_t* AO = (bf16_t*)(p->ws + WS_AO);
    const int r32 = lane & 31, hi = lane >> 5;
    const int row0 = (is_lat ? M_CTX + b * 2048 : b * 256) + qb * 32;
    const int seq0 = is_lat ? M_CTX + b * 2048 : b * 256;
    f32x16 o2[4];
    for (int mp = 0; mp < 2; ++mp) {
        bf16x8 qr[4]; load_q(qr, QKV + (size_t)row0 * 3072 + h * 128 + mp * 64, 3072, r32, hi);
        float m = -1e30f, l = 0.f; zero_o<4>(o2);
        if (is_lat) {
            const bf16_t* vt = VtL + (size_t)((b * 8 + h) * 128) * 2304;
            attn_seg<4, false>(o2, m, l, qr, Kc + (size_t)(b * 256) * 1024 + h * 128 + mp * 64, 1024, vt, 2304, 8, r32, hi, 0, 0);
            attn_seg<4, false>(o2, m, l, qr, QKV + (size_t)seq0 * 3072 + 1024 + h * 128 + mp * 64, 3072, vt + 256, 2304, 64, r32, hi, 0, 0);
        } else {
            attn_seg<4, false>(o2, m, l, qr, QKV + (size_t)seq0 * 3072 + 1024 + h * 128 + mp * 64, 3072, VtC + (size_t)((b * 8 + h) * 128) * 256, 256, 8, r32, hi, 0, 0);
        }
        l += __shfl_xor(l, 32);
        const float il = 1.f / l;
        if (mp == 0) {
#pragma unroll
            for (int dt = 0; dt < 4; ++dt)
#pragma unroll
                for (int r = 0; r < 16; ++r) osm[(dt * 16 + r) * 64 + lane] = o2[dt][r] * il;
        } else {
#pragma unroll
            for (int dt = 0; dt < 4; ++dt)
#pragma unroll
                for (int r = 0; r < 16; ++r) o2[dt][r] = osm[(dt * 16 + r) * 64 + lane] - lam * o2[dt][r] * il;
        }
    }
    f32x16 (&o1)[4] = o2;
    float ss = 0.f;
#pragma unroll
    for (int dt = 0; dt < 4; ++dt)
#pragma unroll
        for (int r = 0; r < 16; ++r) ss += o1[dt][r] * o1[dt][r];
    ss += __shfl_xor(ss, 32);
    const float sc = rsqrtf(ss * (1.f / 128.f) + 1e-6f) * (1.f - lam_init);
    const float* sg = p->in[17] + j * 128;
    bf16_t* orow = AO + (size_t)(row0 + r32) * D + h * 128;
#pragma unroll
    for (int dt = 0; dt < 4; ++dt)
#pragma unroll
        for (int k4 = 0; k4 < 4; ++k4) {
            const int d = dt * 32 + 8 * k4 + 4 * hi; const f32x4 gq = *(const f32x4*)(sg + d);
            u32x2 wv; wv.x = cvtpk(o1[dt][4 * k4] * sc * gq.x, o1[dt][4 * k4 + 1] * sc * gq.y); wv.y = cvtpk(o1[dt][4 * k4 + 2] * sc * gq.z, o1[dt][4 * k4 + 3] * sc * gq.w);
            *(u32x2*)(orow + d) = wv;
        }
}
DI void phase_attn_da(KP p, int layer, int wave, int lane, LAS float* osm) {
    const int j = layer / 3;
    const float* lp = p->in[16] + j * 256;
    const float s1 = wave_sum(lp[lane] * lp[64 + lane]), s2 = wave_sum(lp[128 + lane] * lp[192 + lane]);
    const float lam_init = 0.8f - 0.6f * expf(-0.3f * (float)layer);
    const float lam = expf(s1) - expf(s2) + lam_init;
    const int G = gridDim.x;
    if (wave < 4) {
        for (int u = blockIdx.x * 4 + wave; u < 1024; u += G * 4) { const int qb = u & 63, bh = u >> 6; da_unit(p, layer, true, bh >> 3, bh & 7, qb, lane, lam, lam_init, osm); }
    } else {
        for (int u = blockIdx.x * 4 + (wave - 4); u < 2048; u += G * 4) {
            const int bh = u >> 3, qb = u & 7;
            da_unit(p, layer, false, bh >> 3, bh & 7, qb, lane, lam, lam_init, osm);
        }
    }
}

DI void swa_unit(KP p, bool is_lat, int b, int qh, int qb, int lane) {
    const bf16_t* QKV = (const bf16_t*)(p->ws + WS_QKV); const bf16_t* Kc = (const bf16_t*)(p->ws + WS_KC);
    const bf16_t* VtC = (const bf16_t*)(p->ws + WS_VTC); const bf16_t* VtL = (const bf16_t*)(p->ws + WS_VTL);
    bf16_t* AO = (bf16_t*)(p->ws + WS_AO);
    const int r32 = lane & 31, hi = lane >> 5, kvh = qh >> 2;
    const int seq0 = is_lat ? M_CTX + b * 2048 : b * 256;
    const int row0 = seq0 + qb * 32;
    bf16x8 qr[4]; load_q(qr, QKV + (size_t)row0 * 1536 + qh * 64, 1536, r32, hi);
    f32x16 o[2]; zero_o<2>(o); float m = -1e30f, l = 0.f;
    if (is_lat) {
        const bf16_t* vt = VtL + (size_t)((b * 4 + kvh) * 64) * 2304;
        attn_seg<2, false>(o, m, l, qr, Kc + (size_t)(b * 256) * 256 + kvh * 64, 256, vt, 2304, 8, r32, hi, 0, 0);
        const int q0 = qb * 32; int t0 = q0 - 128; if (t0 < 0) t0 = 0; int t1 = q0 + 160; if (t1 > 2048) t1 = 2048;
        attn_seg<2, true>(o, m, l, qr, QKV + (size_t)(seq0 + t0) * 1536 + 1024 + kvh * 64, 1536, vt + 256 + t0, 2304, (t1 - t0) >> 5, r32, hi, q0 + r32, t0);
    } else {
        attn_seg<2, false>(o, m, l, qr, QKV + (size_t)seq0 * 1536 + 1024 + kvh * 64, 1536, VtC + (size_t)((b * 4 + kvh) * 64) * 256, 256, 8, r32, hi, 0, 0);
    }
    l += __shfl_xor(l, 32);
    l += __builtin_amdgcn_exp2f(p->in[38][qh] * LOG2E - m);
    const float il = 1.f / l;
    bf16_t* orow = AO + (size_t)(row0 + r32) * D + qh * 64;
#pragma unroll
    for (int dt = 0; dt < 2; ++dt)
#pragma unroll
        for (int k4 = 0; k4 < 4; ++k4) {
            const int d = dt * 32 + 8 * k4 + 4 * hi;
            u32x2 wv; wv.x = cvtpk(o[dt][4 * k4] * il, o[dt][4 * k4 + 1] * il); wv.y = cvtpk(o[dt][4 * k4 + 2] * il, o[dt][4 * k4 + 3] * il);
            *(u32x2*)(orow + d) = wv;
        }
}
DI void phase_attn_swa(KP p, int wave, int lane) {
    const int G = gridDim.x;
    for (int u = blockIdx.x * 8 + wave; u < 2048; u += G * 8) { const int qb = u & 63, bq = u >> 6; swa_unit(p, true, bq >> 4, bq & 15, qb, lane); }
    for (int u = blockIdx.x * 8 + wave; u < 4096; u += G * 8) { const int qb = u & 7, bq = u >> 3; swa_unit(p, false, bq >> 4, bq & 15, qb, lane); }
}

struct ScanRun {
    int row0;
    int h, dir;
    int t_first;
    int nsteps;
    int kind;
    const float* init;
    int init_ident;
    bf16_t* yout;
    float* fin;
};
DI void scan_run(KP p, const ScanRun& R, LAS float* sm, int lane) {
    const bf16_t* RKV = (const bf16_t*)(p->ws + WS_B);
    const bf16_t* E = (const bf16_t*)(p->ws + WS_E) + (size_t)R.dir * M_ALL * D;
    const bf16_t* AA = (const bf16_t*)(p->ws + WS_AA) + (size_t)R.dir * M_ALL * D;
    const int rg = lane >> 3, ks = lane & 7;
    const int st = lane >> 3, cs = lane & 7;
    const int hc = R.h * 64 + cs * 8;
    float kkw[8], kaw[8];
#pragma unroll
    for (int e = 0; e < 8; ++e) { kkw[e] = p->in[29][hc + e]; kaw[e] = p->in[30][hc + e]; }
    f32x2 s[8][4];
#pragma unroll
    for (int i = 0; i < 8; ++i)
#pragma unroll
        for (int q = 0; q < 4; ++q) {
            f32x2 v = {0.f, 0.f};
            if (R.init) v = *(const f32x2*)(R.init + (8 * rg + i) * 64 + 8 * ks + 2 * q);
            else if (R.init_ident) { v.x = (8 * rg + i == 8 * ks + 2 * q) ? 1.f : 0.f; v.y = (8 * rg + i == 8 * ks + 2 * q + 1) ? 1.f : 0.f; }
            s[i][q] = v;
        }
    const int sgn = R.dir ? -1 : 1;
    const int nch = R.nsteps >> 3;
    u32x4 gr, gk, gv, ge, ga;
    auto issue = [&](int c) {
        const int t = R.t_first + sgn * (c * 8 + st);
        const size_t row = (size_t)(R.row0 + t);
        gr = *(const u32x4*)(RKV + row * 3072 + hc); gk = *(const u32x4*)(RKV + row * 3072 + 1024 + hc); gv = *(const u32x4*)(RKV + row * 3072 + 2048 + hc);
        ge = *(const u32x4*)(E + row * D + hc); ga = *(const u32x4*)(AA + row * D + hc);
    };
    issue(0);
    for (int c = 0; c < nch; ++c) {
        {
            float fr[8], fk[8], fv[8], fe[8], fa[8];
            unpack8(gr, fr); unpack8(gk, fk); unpack8(gv, fv); unpack8(ge, fe); unpack8(ga, fa);
            float ss = 0.f; float kk[8];
#pragma unroll
            for (int e = 0; e < 8; ++e) { kk[e] = fk[e] * kkw[e]; ss += kk[e] * kk[e]; }
            ss = sum8(ss);
            const float rn = rsqrtf(fmaxf(ss, 1e-24f));
            LAS float* d = sm + st * 384 + cs * 8;
            f32x4 o0, o1;
#pragma unroll
            for (int e = 0; e < 8; ++e) kk[e] *= rn;
            o0 = (f32x4){-kk[0], -kk[1], -kk[2], -kk[3]}; o1 = (f32x4){-kk[4], -kk[5], -kk[6], -kk[7]}; *(LAS f32x4*)(d) = o0; *(LAS f32x4*)(d + 4) = o1;
            float wv[8];
#pragma unroll
            for (int e = 0; e < 8; ++e) wv[e] = __expf(-fe[e]);
            o0 = (f32x4){wv[0], wv[1], wv[2], wv[3]}; o1 = (f32x4){wv[4], wv[5], wv[6], wv[7]}; *(LAS f32x4*)(d + 64) = o0; *(LAS f32x4*)(d + 68) = o1;
            o0 = (f32x4){kk[0] * fa[0], kk[1] * fa[1], kk[2] * fa[2], kk[3] * fa[3]}; o1 = (f32x4){kk[4] * fa[4], kk[5] * fa[5], kk[6] * fa[6], kk[7] * fa[7]}; *(LAS f32x4*)(d + 128) = o0; *(LAS f32x4*)(d + 132) = o1;
            float kd[8];
#pragma unroll
            for (int e = 0; e < 8; ++e) kd[e] = fk[e] * (1.f + (fa[e] - 1.f) * kaw[e]);
            o0 = (f32x4){kd[0], kd[1], kd[2], kd[3]}; o1 = (f32x4){kd[4], kd[5], kd[6], kd[7]}; *(LAS f32x4*)(d + 192) = o0; *(LAS f32x4*)(d + 196) = o1;
            o0 = (f32x4){fr[0], fr[1], fr[2], fr[3]}; o1 = (f32x4){fr[4], fr[5], fr[6], fr[7]}; *(LAS f32x4*)(d + 256) = o0; *(LAS f32x4*)(d + 260) = o1;
            if (R.kind == 1) { o0 = (f32x4){0.f, 0.f, 0.f, 0.f}; o1 = o0; } else { o0 = (f32x4){fv[0], fv[1], fv[2], fv[3]}; o1 = (f32x4){fv[4], fv[5], fv[6], fv[7]}; }
            *(LAS f32x4*)(d + 320) = o0; *(LAS f32x4*)(d + 324) = o1;
        }
        if (c + 1 < nch) issue(c + 1);
        asm volatile("s_waitcnt lgkmcnt(0)" ::: "memory");
#pragma unroll 2
        for (int q8 = 0; q8 < 8; ++q8) {
            const LAS float* b = sm + q8 * 384;
            f32x2 A[4], W[4], Bv[4], KD[4], Rr[4]; float V[8];
            { const f32x4 x0 = *(const LAS f32x4*)(b + 8 * ks), x1 = *(const LAS f32x4*)(b + 8 * ks + 4); A[0] = (f32x2){x0.x, x0.y}; A[1] = (f32x2){x0.z, x0.w}; A[2] = (f32x2){x1.x, x1.y}; A[3] = (f32x2){x1.z, x1.w}; }
            { const f32x4 x0 = *(const LAS f32x4*)(b + 64 + 8 * ks), x1 = *(const LAS f32x4*)(b + 64 + 8 * ks + 4); W[0] = (f32x2){x0.x, x0.y}; W[1] = (f32x2){x0.z, x0.w}; W[2] = (f32x2){x1.x, x1.y}; W[3] = (f32x2){x1.z, x1.w}; }
            { const f32x4 x0 = *(const LAS f32x4*)(b + 128 + 8 * ks), x1 = *(const LAS f32x4*)(b + 128 + 8 * ks + 4); Bv[0] = (f32x2){x0.x, x0.y}; Bv[1] = (f32x2){x0.z, x0.w}; Bv[2] = (f32x2){x1.x, x1.y}; Bv[3] = (f32x2){x1.z, x1.w}; }
            { const f32x4 x0 = *(const LAS f32x4*)(b + 192 + 8 * ks), x1 = *(const LAS f32x4*)(b + 192 + 8 * ks + 4); KD[0] = (f32x2){x0.x, x0.y}; KD[1] = (f32x2){x0.z, x0.w}; KD[2] = (f32x2){x1.x, x1.y}; KD[3] = (f32x2){x1.z, x1.w}; }
            { const f32x4 x0 = *(const LAS f32x4*)(b + 256 + 8 * ks), x1 = *(const LAS f32x4*)(b + 256 + 8 * ks + 4); Rr[0] = (f32x2){x0.x, x0.y}; Rr[1] = (f32x2){x0.z, x0.w}; Rr[2] = (f32x2){x1.x, x1.y}; Rr[3] = (f32x2){x1.z, x1.w}; }
            { const f32x4 x0 = *(const LAS f32x4*)(b + 320 + 8 * rg), x1 = *(const LAS f32x4*)(b + 320 + 8 * rg + 4); V[0] = x0.x; V[1] = x0.y; V[2] = x0.z; V[3] = x0.w; V[4] = x1.x; V[5] = x1.y; V[6] = x1.z; V[7] = x1.w; }
            float sa[8];
#pragma unroll
            for (int i = 0; i < 8; ++i) { f32x2 a2 = s[i][0] * A[0]; a2 += s[i][1] * A[1]; a2 += s[i][2] * A[2]; a2 += s[i][3] * A[3]; sa[i] = a2.x + a2.y; }
#pragma unroll
            for (int i = 0; i < 8; ++i) sa[i] = sum8(sa[i]);
            float y[8];
#pragma unroll
            for (int i = 0; i < 8; ++i) {
                const f32x2 sa2 = {sa[i], sa[i]}, v2 = {V[i], V[i]};
                f32x2 y2 = {0.f, 0.f};
#pragma unroll
                for (int q = 0; q < 4; ++q) { f32x2 tq = s[i][q] * W[q]; tq += sa2 * Bv[q]; tq += v2 * KD[q]; s[i][q] = tq; y2 += tq * Rr[q]; }
                y[i] = y2.x + y2.y;
            }
            if (R.yout) {
#pragma unroll
                for (int i = 0; i < 8; ++i) y[i] = sum8(y[i]);
                if (ks == 0) {
                    const int t = R.t_first + sgn * (c * 8 + q8);
                    *(u32x4*)(R.yout + (size_t)(R.row0 + t) * D + R.h * 64 + 8 * rg) = pack8(y);
                }
            }
        }
        asm volatile("s_waitcnt lgkmcnt(0)" ::: "memory");
    }
    if (R.fin) {
#pragma unroll
        for (int i = 0; i < 8; ++i) {
            float* fp = R.fin + (8 * rg + i) * 64 + 8 * ks;
            *(f32x4*)(fp) = (f32x4){s[i][0].x, s[i][0].y, s[i][1].x, s[i][1].y}; *(f32x4*)(fp + 4) = (f32x4){s[i][2].x, s[i][2].y, s[i][3].x, s[i][3].y};
        }
    }
}
constexpr int LSEG = 128, NSEG = 16;
DI void lat_scan_ids(int scan, int& b, int& h, int& dir) { b = scan >> 5; h = (scan >> 1) & 15; dir = scan & 1; }
DI void phase_scan1(KP p, LAS float* sm, int wave, int lane) {
    const int gw = blockIdx.x * 8 + wave;
    bf16_t* Y = (bf16_t*)(p->ws + WS_Y); float* SEGF = (float*)(p->ws + WS_SEGF);
    for (int slot = gw; slot < 2048; slot += gridDim.x * 8) {
        if (slot < 1024) {
            const int b = slot >> 5, h = (slot >> 1) & 15, dir = slot & 1;
            ScanRun R; R.row0 = b * 256; R.h = h; R.dir = dir; R.t_first = dir ? 255 : 0; R.nsteps = 256; R.kind = 0; R.init = nullptr; R.init_ident = 0;
            R.yout = Y + (size_t)dir * M_ALL * D; R.fin = p->out + O_RW + (size_t)((b * 2 + dir) * 16 + h) * 4096;
            scan_run(p, R, sm, lane);
        } else {
            for (int sub = 0; sub < 2; ++sub) {
                const int q = (slot - 1024) * 2 + sub; if (q >= 1984) break;
                int scan, seg, kind;
                if (q < 1024) { scan = q >> 4; seg = q & 15; kind = 0; } else { const int q2 = q - 1024; scan = q2 / 15; seg = 1 + q2 % 15; kind = 1; }
                int b, h, dir; lat_scan_ids(scan, b, h, dir);
                ScanRun R; R.row0 = M_CTX + b * 2048; R.h = h; R.dir = dir; R.t_first = dir ? (2047 - LSEG * seg) : LSEG * seg; R.nsteps = LSEG; R.kind = kind;
                R.init = (kind == 0 && seg == 0) ? p->in[4] + (size_t)((b * 2 + dir) * 16 + h) * 4096 : nullptr; R.init_ident = kind;
                R.yout = (kind == 0 && seg == 0) ? Y + (size_t)dir * M_ALL * D : nullptr;
                R.fin = SEGF + ((size_t)(scan * NSEG + seg) * 2 + kind) * 4096;
                scan_run(p, R, sm, lane);
            }
        }
    }
}
DI void phase_combine(KP p, LAS float* sm, const int tid) {
    const float* SEGF = (const float*)(p->ws + WS_SEGF); float* TS = (float*)(p->ws + WS_TS);
    for (int scan = blockIdx.x; scan < 64; scan += gridDim.x) {
        const int i = tid >> 3, c0 = (tid & 7) * 8;
        float cur[8];
        { const float* L0 = SEGF + ((size_t)(scan * NSEG + 0) * 2 + 0) * 4096 + i * 64 + c0;
#pragma unroll
          for (int e = 0; e < 8; ++e) cur[e] = L0[e]; }
        for (int k = 1; k < NSEG; ++k) {
            float* Tk = TS + (size_t)(scan * NSEG + k) * 4096 + i * 64 + c0;
#pragma unroll
            for (int e = 0; e < 8; ++e) { Tk[e] = cur[e]; sm[i * 64 + c0 + e] = cur[e]; }
            if (k == NSEG - 1) break;
            __syncthreads();
            const float* Pk = SEGF + ((size_t)(scan * NSEG + k) * 2 + 1) * 4096;
            const float* Lk = SEGF + ((size_t)(scan * NSEG + k) * 2 + 0) * 4096 + i * 64 + c0;
            float acc[8];
#pragma unroll
            for (int e = 0; e < 8; ++e) acc[e] = Lk[e];
            for (int j = 0; j < 64; ++j) { const float tv = sm[i * 64 + j]; const f32x4 p0 = *(const f32x4*)(Pk + j * 64 + c0), p1 = *(const f32x4*)(Pk + j * 64 + c0 + 4);
                acc[0] += tv * p0.x; acc[1] += tv * p0.y; acc[2] += tv * p0.z; acc[3] += tv * p0.w; acc[4] += tv * p1.x; acc[5] += tv * p1.y; acc[6] += tv * p1.z; acc[7] += tv * p1.w; }
#pragma unroll
            for (int e = 0; e < 8; ++e) cur[e] = acc[e];
            __syncthreads();
        }
        __syncthreads();
    }
}
DI void phase_scan2(KP p, LAS float* sm, int wave, int lane) {
    bf16_t* Y = (bf16_t*)(p->ws + WS_Y); const float* TS = (const float*)(p->ws + WS_TS);
    if (wave >= 4) return;
    for (int q2 = blockIdx.x * 4 + wave; q2 < 960; q2 += gridDim.x * 4) {
        const int scan = q2 / 15, seg = 1 + q2 % 15; int b, h, dir; lat_scan_ids(scan, b, h, dir);
        ScanRun R; R.row0 = M_CTX + b * 2048; R.h = h; R.dir = dir; R.t_first = dir ? (2047 - LSEG * seg) : LSEG * seg; R.nsteps = LSEG; R.kind = 0;
        R.init = TS + (size_t)(scan * NSEG + seg) * 4096; R.init_ident = 0; R.yout = Y + (size_t)dir * M_ALL * D; R.fin = nullptr;
        scan_run(p, R, sm, lane);
    }
}
DI void phase_rwkv_post(KP p, const WaveCtx& w) {
    const bf16_t* RKV = (const bf16_t*)(p->ws + WS_B); const bf16_t* AA = (const bf16_t*)(p->ws + WS_AA); const bf16_t* Y = (const bf16_t*)(p->ws + WS_Y);
    const bf16_t* Gt = (const bf16_t*)(p->ws + WS_RG); bf16_t* AO = (bf16_t*)(p->ws + WS_RAO);
    for (int u = w.gw; u < M_ALL * 2; u += w.ngw) {
        const int row = u >> 1, c0 = (u & 1) * 512 + w.lane * 8;
        float yf[8], yb[8], r[8], k[8], v[8], a0[8], a1[8], g[8];
        unpack8(*(const u32x4*)(Y + (size_t)row * D + c0), yf); unpack8(*(const u32x4*)(Y + (size_t)(M_ALL + row) * D + c0), yb);
        unpack8(*(const u32x4*)(RKV + (size_t)row * 3072 + c0), r); unpack8(*(const u32x4*)(RKV + (size_t)row * 3072 + 1024 + c0), k); unpack8(*(const u32x4*)(RKV + (size_t)row * 3072 + 2048 + c0), v);
        unpack8(*(const u32x4*)(AA + (size_t)row * D + c0), a0); unpack8(*(const u32x4*)(AA + (size_t)(M_ALL + row) * D + c0), a1);
        unpack8(*(const u32x4*)(Gt + (size_t)row * D + c0), g);
        float y[8], sy = 0.f, bo = 0.f;
#pragma unroll
        for (int e = 0; e < 8; ++e) { y[e] = yf[e] + yb[e]; sy += y[e];
            const float ka = p->in[30][c0 + e]; bo += r[e] * p->in[31][c0 + e] * k[e] * (2.f + (a0[e] + a1[e] - 2.f) * ka); }
        const float mu = sum8(sy) * (1.f / 64.f); bo = sum8(bo);
        float sv = 0.f;
#pragma unroll
        for (int e = 0; e < 8; ++e) { y[e] -= mu; sv += y[e] * y[e]; }
        const float rstd = rsqrtf(sum8(sv) * (1.f / 64.f) + 64e-5f);
        float o[8];
#pragma unroll
        for (int e = 0; e < 8; ++e) o[e] = (y[e] * rstd * p->in[32][c0 + e] + p->in[33][c0 + e] + bo * v[e]) * g[e];
        *(u32x4*)(AO + (size_t)row * D + c0) = pack8(o);
    }
}

constexpr int LDS_BYTES = 147456;
constexpr int NPHASES = 37;

#ifndef N_LAUNCH_MODE
#define N_LAUNCH_MODE 1
#endif
enum Op { OP_P0 = 0, OP_NORM, OP_GEMM_QKV, OP_QKPREP, OP_ATTN, OP_GEMM_WO, OP_NORM_R, OP_GEMM_S1, OP_GEMM_S2A, OP_GEMM_S2B, OP_SCAN1, OP_COMBINE, OP_SCAN2, OP_POST, OP_NORM_MLP, OP_GEMM_UP, OP_GEMM_DOWN };
#ifndef PHMASK
#define PHMASK 0xFFFFFFFFu
#endif
__host__ __device__ inline void decode_phase(int pc, int& layer, int& op) {
    if (pc == 0) { layer = 0; op = OP_P0; return; }
    int r = pc - 1;
    if (r < 8) layer = 0; else if (r < 20) { layer = 1; r -= 8; } else if (r < 28) { layer = 2; r -= 20; } else { layer = 3; r -= 28; }
    if (layer != 1) { op = (r < 5) ? (OP_NORM + r) : (OP_NORM_MLP + (r - 5)); }
    else { op = (r < 8) ? (OP_NORM_R + r) : (r == 8 ? OP_GEMM_WO : OP_NORM_MLP + (r - 9)); }
}
DI void run_op(KP p, int layer, int op, LAS unsigned char* lds, const int tid) {
        const int lane = tid & 63, wave = __builtin_amdgcn_readfirstlane(tid >> 6);
        WaveCtx w; w.gw = blockIdx.x * 8 + wave; w.ngw = gridDim.x * 8; w.lane = lane; w.scr = (LAS float*)(lds + wave * 16384);
        const int kind = layer % 3, j = layer / 3;
        const float* modl = (const float*)(p->ws + WS_MOD) + (size_t)layer * 3 * MODW;
        int gk = 0;
        const bf16_t* gA = nullptr; const bf16_t* gB = nullptr; int lda = 0, ldb = 0, gN = 0, gK = 0;
        EpiAct EA{nullptr, 0, 0, nullptr, 0, nullptr, nullptr}; EpiRes ER{p->out + O_X, nullptr};
        if (!((PHMASK >> op) & 1u)) op = -1;
        switch (op) {
        case OP_P0: phase_mod(p, lds, tid); convert_mixer_weights(p, w, 0); break;
        case OP_NORM: if (layer > 0) convert_mixer_weights(p, w, layer); phase_norm(p, w, layer, 0); break;
        case OP_GEMM_QKV: { const int ldq = kind == 0 ? 3072 : 1536; gk = 1; gA = (const bf16_t*)(p->ws + WS_A); lda = D; gB = (const bf16_t*)(p->ws + WS_WQKVT); ldb = D; gN = ldq; gK = D;
            EA.O = (bf16_t*)(p->ws + WS_QKV); EA.ldc = ldq; EA.mode = 0; } break;
        case OP_QKPREP: { const AttnCfg cfg = make_cfg(p, kind, j); phase_qkprep(p, w, cfg, lds + wave * 16384); } break;
        case OP_ATTN: if (kind == 0) phase_attn_da(p, layer, wave, lane, (LAS float*)(lds + wave * 16384)); else phase_attn_swa(p, wave, lane); break;
        case OP_GEMM_WO: gk = 2; gA = (const bf16_t*)(p->ws + (kind == 1 ? WS_RAO : WS_AO)); lda = D; gB = (const bf16_t*)(p->ws + (kind == 1 ? WS_RWO : WS_WOT)); ldb = D; gN = D; gK = D; ER.gate3 = modl + 2 * D; break;
        case OP_NORM_R: convert_mixer_weights(p, w, layer); phase_norm_rwkv(p, w, layer); break;
        case OP_GEMM_S1: gk = 1; gA = (const bf16_t*)(p->ws + WS_A); lda = 2048; gB = (const bf16_t*)(p->ws + WS_S1T); ldb = 2048; gN = 3584; gK = 2048;
            EA.O = (bf16_t*)(p->ws + WS_B); EA.ldc = 3072; EA.mode = 2; EA.O2 = (bf16_t*)(p->ws + WS_LORA); EA.ldc2 = 512; break;
        case OP_GEMM_S2A: gk = 1; gA = (const bf16_t*)(p->ws + WS_LORA); lda = 512; gB = (const bf16_t*)(p->ws + WS_S2T); ldb = 256; gN = 4096; gK = 256;
            EA.O = (bf16_t*)(p->ws + WS_E); EA.ldc = D; EA.mode = 3; EA.O2 = (bf16_t*)(p->ws + WS_AA); EA.ldc2 = D; EA.b0 = p->in[21]; EA.b1 = p->in[24]; break;
        case OP_GEMM_S2B: gk = 1; gA = (const bf16_t*)(p->ws + WS_LORA) + 256; lda = 512; gB = (const bf16_t*)(p->ws + WS_G2T); ldb = 256; gN = D; gK = 256;
            EA.O = (bf16_t*)(p->ws + WS_RG); EA.ldc = D; EA.mode = 0; break;
        case OP_SCAN1: phase_scan1(p, (LAS float*)(lds + wave * 12288), wave, lane); break;
        case OP_COMBINE: phase_combine(p, (LAS float*)lds, tid); break;
        case OP_SCAN2: phase_scan2(p, (LAS float*)(lds + wave * 12288), wave, lane); break;
        case OP_POST: phase_rwkv_post(p, w); break;
        case OP_NORM_MLP: convert_mlp_weights(p, w, layer); phase_norm(p, w, layer, 1); break;
        case OP_GEMM_UP: gk = 1; gA = (const bf16_t*)(p->ws + WS_A); lda = D; gB = (const bf16_t*)(p->ws + WS_W1T); ldb = D; gN = FFD; gK = D;
            EA.O = (bf16_t*)(p->ws + WS_B); EA.ldc = FFD; EA.mode = 1; break;
        case OP_GEMM_DOWN: gk = 2; gA = (const bf16_t*)(p->ws + WS_B); lda = FFD; gB = (const bf16_t*)(p->ws + WS_W2T); ldb = FFD; gN = D; gK = FFD; ER.gate3 = modl + 5 * D; break;
        default: break;
        }
        if (gk == 1) run_gemm(lds, gA, lda, gB, ldb, gN, gK, EA, tid);
        else if (gk == 2) run_gemm(lds, gA, lda, gB, ldb, gN, gK, ER, tid);
}

#if N_LAUNCH_MODE == 1
__global__ void __launch_bounds__(512, 2) trunk_fwd(Params p_) {
    extern __shared__ __attribute__((aligned(16))) unsigned char lds_raw[];
    LAS unsigned char* lds = (LAS unsigned char*)lds_raw;
    cg::grid_group grid = cg::this_grid();
    const int ph_lo = p_.ph_lo, ph_hi = p_.ph_hi;
    for (int pc = ph_lo; pc < ph_hi; ++pc) {
        KP p = (KP)__builtin_amdgcn_kernarg_segment_ptr(); asm volatile("" : "+s"(p));
        int layer, op; decode_phase(pc, layer, op);
        int tid = threadIdx.x; asm volatile("" : "+v"(tid));
        run_op(p, layer, op, lds, tid);
        if (pc + 1 < ph_hi) grid.sync();
    }
}
#else
template <int OP> __global__ void __launch_bounds__(512, 2) k_op(Params p_) {
    extern __shared__ __attribute__((aligned(16))) unsigned char lds_raw[];
    KP p = (KP)__builtin_amdgcn_kernarg_segment_ptr();
    run_op(p, p_.ph_lo, OP, (LAS unsigned char*)lds_raw, threadIdx.x);
}

#endif
extern "C" void kernel_launch(void* const* d_in, const int* in_sizes, int n_in, void* d_out, int out_size, void* d_ws, size_t ws_size, hipStream_t stream) {
    static int grid = 0;
    if (grid == 0) {
        if (n_in != 40 || ws_size < WS_END || out_size != 54525952) { fprintf(stderr, "kernel_launch: unexpected problem (n_in %d, ws %zu, out %d)\n", n_in, ws_size, out_size); grid = -1; return; }
        int dev = 0, cus = 0, per_cu = 0;
        if (hipGetDevice(&dev) != hipSuccess || hipDeviceGetAttribute(&cus, hipDeviceAttributeMultiprocessorCount, dev) != hipSuccess) { grid = -1; return; }
#if N_LAUNCH_MODE == 1
        if (hipFuncSetAttribute((const void*)trunk_fwd, hipFuncAttributeMaxDynamicSharedMemorySize, LDS_BYTES) != hipSuccess) { fprintf(stderr, "kernel_launch: hipFuncSetAttribute failed\n"); grid = -1; return; }
        if (hipOccupancyMaxActiveBlocksPerMultiprocessor(&per_cu, (const void*)trunk_fwd, 512, LDS_BYTES) != hipSuccess || per_cu < 1) { fprintf(stderr, "kernel_launch: occupancy query says %d\n", per_cu); grid = -1; return; }
#else
        per_cu = 1;
#endif
        grid = cus * per_cu;
        if (grid > 256) grid = 256;
    }
    if (grid < 0) return;
    Params p{};
    for (int i = 0; i < 40; ++i) p.in[i] = (const float*)d_in[i];
    p.out = (float*)d_out; p.ws = (unsigned char*)d_ws;
#if N_LAUNCH_MODE == 1
    p.ph_lo = 0; p.ph_hi = NPHASES;
    void* args[] = {&p};
    hipError_t e = hipLaunchCooperativeKernel((const void*)trunk_fwd, dim3(grid), dim3(512), args, LDS_BYTES, stream);
    if (e != hipSuccess) fprintf(stderr, "cooperative launch failed: %s (grid %d)\n", hipGetErrorString(e), grid);
#else
    for (int ph = 0; ph < NPHASES; ++ph) {
        int layer, op; decode_phase(ph, layer, op);
        p.ph_lo = layer; p.ph_hi = 0;
#define LOP(X) case X: { static bool once##X = false; if (!once##X) { (void)hipFuncSetAttribute((const void*)k_op<X>, hipFuncAttributeMaxDynamicSharedMemorySize, LDS_BYTES); once##X = true; } hipLaunchKernelGGL(k_op<X>, dim3(grid), dim3(512), LDS_BYTES, stream, p); } break;
        switch (op) { LOP(0) LOP(1) LOP(2) LOP(3) LOP(4) LOP(5) LOP(6) LOP(7) LOP(8) LOP(9) LOP(10) LOP(11) LOP(12) LOP(13) LOP(14) LOP(15) LOP(16) default: break; }
#undef LOP
    }
#endif
}
```

```cpp
#include <hip/hip_runtime.h>
#include <hip/hip_cooperative_groups.h>
#include <cstdio>
#include <cstdint>
namespace cg = cooperative_groups;
#define DI __device__ __forceinline__
namespace pg8 {
#define PG8_LAS __attribute__((address_space(3)))
typedef unsigned short bf16_t;
typedef short bf16x8 __attribute__((ext_vector_type(8)));
typedef float f32x4 __attribute__((ext_vector_type(4)));
typedef unsigned u32x4 __attribute__((ext_vector_type(4)));
constexpr int BM = 256, BK = 64, HALF = 128, HTB = HALF * BK * 2  , STAGE_BYTES = 8 * HTB, NXCD = 8, WGM = 8;

__host__ __device__ __forceinline__ int lds_byte(int r, int c) { const int st = (r >> 4) * 2 + (c >> 5), rr = r & 15, cc = c & 31, ob = rr * 64 + cc * 2; return st * 1024 + (ob ^ (((ob >> 9) & 1) << 5)); }
__host__ __device__ __forceinline__ void stage_rc(int b, int& R, int& C) { const int st = b / 1024, sb = b % 1024, swz = sb ^ (((sb >> 9) & 1) << 5); R = (st >> 1) * 16 + swz / 64; C = (st & 1) * 32 + (swz % 64) / 2; }
__host__ __device__ __forceinline__ int perm32(int rho) { const int n = rho >> 4, i = rho & 15; return 8 * (i >> 2) + 4 * n + (i & 3); }

struct Unit { int pm, pn; };
struct Gemm { const bf16_t* A; const bf16_t* Bt; int lda, ldb, M, N, K; };

struct StaticOrder {
    int nM, nN, nwg, G, c;
    __host__ __device__ void init(int M, int N, int G_, int c_) { nM = M / BM; nN = N / BM; nwg = nM * nN; G = G_; c = c_; }
    __host__ __device__ bool next(int i, Unit& u) const {
        const long L = (long)i * G + c; if (L >= nwg) return false;
        int wgid = (int)L; { const int q = nwg / NXCD, r = nwg % NXCD, xcd = wgid % NXCD, off = wgid / NXCD; wgid = (xcd < r ? xcd * (q + 1) : r * (q + 1) + (xcd - r) * q) + off; }
        const int nig = WGM * nN, gid = wgid / nig, fm = gid * WGM, gsz = (nM - fm) < WGM ? (nM - fm) : WGM;
        u.pm = fm + ((wgid % nig) % gsz); u.pn = (wgid % nig) / gsz; return true;
    }
    __device__ __forceinline__ void a_ready(const Unit&) const {}
    __device__ __forceinline__ void done(const Unit&) const {}
};


template <class Epi, class Sched, bool ALIGN_EPI = false, bool SP2 = false>
__device__ __forceinline__ void gemm_phase(PG8_LAS unsigned char* lds, const Gemm g, const Sched& S, const Epi& E, const int tid) {
    const int wid = __builtin_amdgcn_readfirstlane(tid >> 6), lane = tid & 63, wr = wid >> 2, wc = wid & 3, fr = lane & 15, fq = lane >> 4;
    const int K = g.K, nt = K / BK;
    unsigned voffA[2], voffB[2];
#pragma unroll
    for (int i = 0; i < 2; ++i) { int R, C; stage_rc(tid * 16 + i * 8192, R, C); const int Rb = Epi::PERM ? ((R & ~31) + perm32(R & 31)) : R;
        voffA[i] = (unsigned)(R * g.lda + C) * 2u; voffB[i] = (unsigned)(Rb * g.ldb + C) * 2u; }
    const size_t kstep = (size_t)(BK * 2);
    const size_t hstepA = (size_t)HALF * g.lda * 2, hstepB = (size_t)HALF * g.ldb * 2;
    const size_t tstepA = 2 * hstepA, tstepB = 2 * hstepB;
    const unsigned ldsw = (unsigned)wid * 1024u;
    const int aoff = lds_byte(wr * 64 + fr, fq * 8), boff = lds_byte(wc * 32 + fr, fq * 8);
#define PG8_SA(b, h) (((b) * 2 + (h)) * HTB)
#define PG8_SB(b, h) ((4 + (b) * 2 + (h)) * HTB)
#define PG8_STAGE(bufoff, gbase, voff) do { _Pragma("unroll") for (int _i = 0; _i < 2; ++_i) \
        __builtin_amdgcn_global_load_lds((const unsigned*)((const char*)(gbase) + (voff)[_i]), (PG8_LAS unsigned*)(lds + (bufoff) + ldsw + _i * 8192), 16, 0, 0); } while (0)
#define PG8_LDA(dst, b, h) do { _Pragma("unroll") for (int m = 0; m < 4; ++m) _Pragma("unroll") for (int k = 0; k < 2; ++k) dst[m][k] = *(const PG8_LAS bf16x8*)(lds + PG8_SA(b, h) + aoff + m * 2048 + k * 1024); } while (0)
#define PG8_LDB(dst, b, h) do { _Pragma("unroll") for (int n = 0; n < 2; ++n) _Pragma("unroll") for (int k = 0; k < 2; ++k) dst[n][k] = *(const PG8_LAS bf16x8*)(lds + PG8_SB(b, h) + boff + n * 2048 + k * 1024); } while (0)
#define PG8_MMA(ai, bj, At, Bt) do { __builtin_amdgcn_s_setprio(1); _Pragma("unroll") for (int m = 0; m < 4; ++m) _Pragma("unroll") for (int n = 0; n < 2; ++n) _Pragma("unroll") for (int k = 0; k < 2; ++k) \
        acc[ai][bj][m][n] = __builtin_amdgcn_mfma_f32_16x16x32_bf16(Bt[n][k], At[m][k], acc[ai][bj][m][n], 0, 0, 0); __builtin_amdgcn_s_setprio(0); } while (0)
#define PG8_WAIT_V(n) asm volatile("s_waitcnt vmcnt(" #n ")" ::: "memory")
#define PG8_WAIT_L(n) asm volatile("s_waitcnt lgkmcnt(" #n ")" ::: "memory")
#define PG8_BAR __builtin_amdgcn_s_barrier()
#define PG8_SCHED __builtin_amdgcn_sched_barrier(0)
    Unit cur, nxt; int ui = 0;
    if (!S.next(0, cur)) return;
    f32x4 acc[2][2][4][2];
#pragma unroll
    for (int a = 0; a < 2; ++a)
#pragma unroll
        for (int b = 0; b < 2; ++b)
#pragma unroll
            for (int m = 0; m < 4; ++m)
#pragma unroll
                for (int n = 0; n < 2; ++n) acc[a][b][m][n] = (f32x4){0.f, 0.f, 0.f, 0.f};
    bf16x8 At[4][2], B0[2][2], B1[2][2];
    const char* cA = (const char*)g.A + (size_t)cur.pm * tstepA; const char* cB = (const char*)g.Bt + (size_t)cur.pn * tstepB;
    S.a_ready(cur);
    if constexpr (SP2) {
        PG8_STAGE(PG8_SB(0, 0), cB, voffB); PG8_STAGE(PG8_SB(0, 1), cB + hstepB, voffB); PG8_STAGE(PG8_SA(0, 0), cA, voffA); PG8_STAGE(PG8_SA(0, 1), cA + hstepA, voffA);
        if (wr == 1) PG8_BAR;
        PG8_WAIT_V(2); PG8_BAR;
        PG8_STAGE(PG8_SB(1, 0), cB + kstep, voffB); PG8_STAGE(PG8_SA(1, 0), cA + kstep, voffA); PG8_STAGE(PG8_SB(1, 1), cB + hstepB + kstep, voffB);
        PG8_WAIT_V(6); PG8_BAR;
    } else {
        PG8_STAGE(PG8_SB(0, 0), cB, voffB); PG8_STAGE(PG8_SA(0, 0), cA, voffA); PG8_STAGE(PG8_SB(0, 1), cB + hstepB, voffB); PG8_STAGE(PG8_SA(0, 1), cA + hstepA, voffA);
        if (wr == 1) PG8_BAR;
        PG8_WAIT_V(4); PG8_BAR;
        PG8_STAGE(PG8_SB(1, 0), cB + kstep, voffB); PG8_STAGE(PG8_SA(1, 0), cA + kstep, voffA); PG8_STAGE(PG8_SB(1, 1), cB + hstepB + kstep, voffB);
        PG8_WAIT_V(6); PG8_BAR;
    }
    for (;;) {
        const bool has_next = S.next(ui + 1, nxt);
        const char* nA = has_next ? (const char*)g.A + (size_t)nxt.pm * tstepA : cA; const char* nB = has_next ? (const char*)g.Bt + (size_t)nxt.pn * tstepB : cB;
        for (int t = 0; t < nt; t += 2) {
            const bool last = (t == nt - 2);
            const char* a1 = cA + (size_t)(t + 1) * kstep;
            const char* a2 = last ? nA : cA + (size_t)(t + 2) * kstep; const char* b2 = last ? nB : cB + (size_t)(t + 2) * kstep;
            const char* a3 = a2 + kstep; const char* b3 = b2 + kstep;
            if (last && has_next) S.a_ready(nxt);
            if constexpr (SP2) {
            PG8_LDB(B0, 0, 0); PG8_LDB(B1, 0, 1); PG8_SCHED; PG8_LDA(At, 0, 0); PG8_STAGE(PG8_SA(1, 1), a1 + hstepA, voffA);
            PG8_WAIT_V(8); PG8_WAIT_L(0); PG8_BAR; PG8_MMA(0, 0, At, B0); PG8_MMA(0, 1, At, B1); PG8_BAR; PG8_SCHED;
            PG8_LDA(At, 0, 1); PG8_STAGE(PG8_SB(0, 0), b2, voffB); PG8_STAGE(PG8_SB(0, 1), b2 + hstepB, voffB); PG8_STAGE(PG8_SA(0, 0), a2, voffA);
            PG8_WAIT_V(8); PG8_WAIT_L(0); PG8_BAR; PG8_MMA(1, 0, At, B0); PG8_MMA(1, 1, At, B1); PG8_BAR; PG8_SCHED;
            PG8_LDB(B0, 1, 0); PG8_LDB(B1, 1, 1); PG8_SCHED; PG8_LDA(At, 1, 0); PG8_STAGE(PG8_SA(0, 1), a2 + hstepA, voffA);
            PG8_WAIT_V(8); PG8_WAIT_L(0); PG8_BAR; PG8_MMA(0, 0, At, B0); PG8_MMA(0, 1, At, B1); PG8_BAR; PG8_SCHED;
            PG8_LDA(At, 1, 1); PG8_STAGE(PG8_SB(1, 0), b3, voffB); PG8_STAGE(PG8_SB(1, 1), b3 + hstepB, voffB); PG8_STAGE(PG8_SA(1, 0), a3, voffA);
            PG8_WAIT_V(8); PG8_WAIT_L(0); PG8_BAR; PG8_MMA(1, 0, At, B0); PG8_MMA(1, 1, At, B1); PG8_BAR; PG8_SCHED;
            } else {
            PG8_LDB(B0, 0, 0); PG8_SCHED; PG8_LDA(At, 0, 0); PG8_STAGE(PG8_SA(1, 1), a1 + hstepA, voffA);
            PG8_WAIT_L(8); PG8_BAR; PG8_WAIT_L(0); PG8_MMA(0, 0, At, B0); PG8_BAR; PG8_SCHED;
            PG8_LDB(B1, 0, 1); PG8_STAGE(PG8_SB(0, 0), b2, voffB);
            PG8_BAR; PG8_WAIT_L(0); PG8_MMA(0, 1, At, B1); PG8_BAR;
            PG8_LDA(At, 0, 1); PG8_STAGE(PG8_SA(0, 0), a2, voffA);
            PG8_BAR; PG8_WAIT_L(0); PG8_MMA(1, 0, At, B0); PG8_BAR; PG8_SCHED;
            PG8_STAGE(PG8_SB(0, 1), b2 + hstepB, voffB);
            PG8_WAIT_V(6); PG8_BAR; PG8_MMA(1, 1, At, B1); PG8_BAR;
            PG8_LDB(B0, 1, 0); PG8_SCHED; PG8_LDA(At, 1, 0); PG8_STAGE(PG8_SA(0, 1), a2 + hstepA, voffA);
            PG8_WAIT_L(8); PG8_BAR; PG8_WAIT_L(0); PG8_MMA(0, 0, At, B0); PG8_BAR; PG8_SCHED;
            PG8_LDB(B1, 1, 1); PG8_STAGE(PG8_SB(1, 0), b3, voffB);
            PG8_BAR; PG8_WAIT_L(0); PG8_MMA(0, 1, At, B1); PG8_BAR;
            PG8_LDA(At, 1, 1); PG8_STAGE(PG8_SA(1, 0), a3, voffA);
            PG8_BAR; PG8_WAIT_L(0); PG8_MMA(1, 0, At, B0); PG8_BAR; PG8_SCHED;
            PG8_STAGE(PG8_SB(1, 1), b3 + hstepB, voffB);
            PG8_WAIT_V(6); PG8_BAR; PG8_MMA(1, 1, At, B1); PG8_BAR;
            }
        }
        if constexpr (ALIGN_EPI) { if (wr == 0) PG8_BAR; }
        if constexpr (!Epi::AFTER_DRAIN) { E(acc, cur, wr, wc, fr, fq); S.done(cur); }
        if (!has_next) break;
#pragma unroll
        for (int a = 0; a < 2; ++a)
#pragma unroll
            for (int b = 0; b < 2; ++b)
#pragma unroll
                for (int m = 0; m < 4; ++m)
#pragma unroll
                    for (int n = 0; n < 2; ++n) acc[a][b][m][n] = (f32x4){0.f, 0.f, 0.f, 0.f};
        cur = nxt; cA = nA; cB = nB; ++ui;
        if constexpr (ALIGN_EPI) { if (wr == 1) PG8_BAR; }
    }
    PG8_WAIT_V(0);
    if constexpr (!ALIGN_EPI) { if (wr == 0) PG8_BAR; }
    PG8_BAR;
    if constexpr (Epi::AFTER_DRAIN) { E.fused(acc, cur, wr, wc, fr, fq, lds, wid, lane); S.done(cur); }
#undef PG8_SA
#undef PG8_SB
#undef PG8_STAGE
#undef PG8_LDA
#undef PG8_LDB
#undef PG8_MMA
#undef PG8_WAIT_V
#undef PG8_WAIT_L
#undef PG8_BAR
#undef PG8_SCHED
}
}


#define LAS __attribute__((address_space(3)))
typedef unsigned short bf16_t;
typedef short bf16x8 __attribute__((ext_vector_type(8)));
typedef float f32x4 __attribute__((ext_vector_type(4)));
typedef float f32x2 __attribute__((ext_vector_type(2)));
typedef float f32x16 __attribute__((ext_vector_type(16)));
typedef unsigned u32x4 __attribute__((ext_vector_type(4)));
typedef unsigned u32x2 __attribute__((ext_vector_type(2)));
typedef __bf16 bf16x2_t __attribute__((ext_vector_type(2)));

constexpr int D = 1024, FFD = 4096, M_CTX = 8192, M_LAT = 4096, M_ALL = 12288, T_CTX = 256, T_LAT = 2048, NPAST = 256;
constexpr int MODW = 6144;
constexpr size_t MiB = 1u << 20;
constexpr size_t O_X = 0, O_DAK = 12582912, O_DAV = 29360128, O_RW = 46137344, O_SWK = 50331648, O_SWV = 52428800;
constexpr size_t WS_MOD = 0;
constexpr size_t WS_BAR = 400 * 1024;
constexpr size_t WS_ROPE = 512 * 1024;
constexpr size_t WS_SEGF = 1 * MiB;
constexpr size_t WS_W = 33 * MiB;
constexpr size_t WS_A = 53 * MiB;
constexpr size_t WS_B = 101 * MiB;
constexpr size_t WS_C = 197 * MiB;
constexpr size_t WS_END = 341 * MiB;
constexpr size_t WS_W1T = WS_A + 24 * MiB, WS_W2T = WS_A + 32 * MiB;
constexpr size_t WS_QKV = WS_B, WS_AO = WS_B + 72 * MiB;
constexpr size_t WS_LORA = WS_B + 72 * MiB;
constexpr size_t WS_RG = WS_A, WS_RAO = WS_A + 24 * MiB, WS_TS = WS_A + 24 * MiB;
constexpr size_t WS_E = WS_C, WS_AA = WS_C + 48 * MiB, WS_Y = WS_C + 96 * MiB;
constexpr size_t WS_VTC = WS_C, WS_VTL = WS_C + 32 * MiB, WS_KC = WS_C + 48 * MiB;
constexpr size_t WS_S1T = WS_W;
constexpr size_t WS_S2T = WS_W + 14 * MiB;
constexpr size_t WS_G2T = WS_W + 16 * MiB;
constexpr size_t WS_RWO = WS_W + 17 * MiB;
constexpr size_t WS_WQKVT = WS_W, WS_WOT = WS_W + 8 * MiB;

constexpr float LOG2E = 1.4426950408889634f;
constexpr float QSCALE = 0.125f * LOG2E;

struct Params { const float* in[40]; float* out; unsigned char* ws; int ph_lo, ph_hi; };
typedef const __attribute__((address_space(4))) Params* KP;

DI unsigned cvtpk(float lo, float hi) { f32x2 v = {lo, hi}; bf16x2_t b = __builtin_convertvector(v, bf16x2_t); return __builtin_bit_cast(unsigned, b); }
DI float bflo(unsigned w) { return __uint_as_float(w << 16); }
DI float bfhi(unsigned w) { return __uint_as_float(w & 0xffff0000u); }
DI float bf2f(bf16_t b) { return __uint_as_float(((unsigned)b) << 16); }
DI void unpack8(const u32x4 w, float (&f)[8]) { f[0] = bflo(w.x); f[1] = bfhi(w.x); f[2] = bflo(w.y); f[3] = bfhi(w.y); f[4] = bflo(w.z); f[5] = bfhi(w.z); f[6] = bflo(w.w); f[7] = bfhi(w.w); }
DI u32x4 pack8(const float (&f)[8]) { u32x4 w; w.x = cvtpk(f[0], f[1]); w.y = cvtpk(f[2], f[3]); w.z = cvtpk(f[4], f[5]); w.w = cvtpk(f[6], f[7]); return w; }
template <int CTRL> DI float dpp_mov(float v) { return __uint_as_float((unsigned)__builtin_amdgcn_update_dpp(0, (int)__float_as_uint(v), CTRL, 0xF, 0xF, true)); }
DI float sum2(float v) { v += dpp_mov<0xB1>(v); return v; }
DI float sum8(float v) { v += dpp_mov<0xB1>(v); v += dpp_mov<0x4E>(v); v += dpp_mov<0x141>(v); return v; }
DI float wave_sum(float v) {
#pragma unroll
    for (int o = 1; o < 64; o <<= 1) v += __shfl_xor(v, o);
    return v;
}
DI float sigmoidf_(float x) { return 1.f / (1.f + __expf(-x)); }
DI int cond_of_row(int row) { return row < M_CTX ? 0 : (row < M_CTX + T_LAT ? 1 : 2); }

struct EpiAct {
    static constexpr bool PERM = true, AFTER_DRAIN = false;
    bf16_t* O; int ldc; int mode; bf16_t* O2; int ldc2; const float* b0; const float* b1;
    DI void operator()(const pg8::f32x4 (&acc)[2][2][4][2], const pg8::Unit& u, int wr, int wc, int fr, int fq) const {
        const int row0 = u.pm * 256 + wr * 64 + fr;
        bf16_t* base = O; int ld = ldc; int colt = u.pn * 256; int act0 = 0, act1 = 0; const float* bias = nullptr; float cmul = 1.f;
        if (mode == 1) { act0 = act1 = 1; }
        else if (mode == 2) { if (u.pn >= 12) { base = O2; ld = ldc2; colt = (u.pn - 12) * 256; act0 = (u.pn == 12) ? 2 : 3; act1 = 0; } }
        else if (mode == 3) { act0 = act1 = 4; if (u.pn < 8) { bias = b0 + u.pn * 256; cmul = 0.6065306597126334f; base = O + (size_t)(u.pn >> 2) * M_ALL * D; colt = (u.pn & 3) * 256; }
                              else { bias = b1 + (u.pn - 8) * 256; base = O2 + (size_t)((u.pn - 8) >> 2) * M_ALL * D; colt = (u.pn & 3) * 256; ld = ldc2; } }
        const int cw = wc * 32 + 8 * fq;
#pragma unroll
        for (int ai = 0; ai < 2; ++ai)
#pragma unroll
            for (int m = 0; m < 4; ++m) {
                bf16_t* rowp = base + (size_t)(row0 + ai * 128 + m * 16) * ld + colt + cw;
#pragma unroll
                for (int bj = 0; bj < 2; ++bj) {
                    const int act = bj ? act1 : act0;
                    float v[8];
#pragma unroll
                    for (int j = 0; j < 4; ++j) { v[j] = acc[ai][bj][m][0][j]; v[4 + j] = acc[ai][bj][m][1][j]; }
                    if (act == 1) {
#pragma unroll
                        for (int j = 0; j < 8; ++j) { const float r = fmaxf(v[j], 0.f); v[j] = r * r; }
                    } else if (act == 2) {
#pragma unroll
                        for (int j = 0; j < 8; ++j) { const float e2 = __expf(2.f * v[j]); v[j] = 1.f - 2.f / (e2 + 1.f); }
                    } else if (act == 3) {
#pragma unroll
                        for (int j = 0; j < 8; ++j) v[j] = sigmoidf_(v[j]);
                    } else if (act == 4) {
                        const float* bp = bias + bj * 128 + cw;
#pragma unroll
                        for (int j = 0; j < 8; ++j) v[j] = cmul * sigmoidf_(v[j] + bp[j]);
                    }
                    *(u32x4*)(rowp + bj * 128) = pack8(v);
                }
            }
    }
};
struct EpiRes {
    static constexpr bool PERM = false, AFTER_DRAIN = false;
    float* X; const float* gate3;
    DI void operator()(const pg8::f32x4 (&acc)[2][2][4][2], const pg8::Unit& u, int wr, int wc, int fr, int fq) const {
        const int cond = u.pm < 32 ? 0 : (u.pm < 40 ? 1 : 2);
        const float* g = gate3 + cond * MODW;
        const int col0 = u.pn * 256 + wc * 32 + 4 * fq, row0 = u.pm * 256 + wr * 64 + fr;
#pragma unroll
        for (int bj = 0; bj < 2; ++bj)
#pragma unroll
            for (int n = 0; n < 2; ++n) {
                const int col = col0 + bj * 128 + n * 16;
                const f32x4 gv = *(const f32x4*)(g + col);
#pragma unroll
                for (int ai = 0; ai < 2; ++ai)
#pragma unroll
                    for (int m = 0; m < 4; ++m) {
                        float* p = X + (size_t)(row0 + ai * 128 + m * 16) * D + col;
                        f32x4 v = *(const f32x4*)p; v += gv * acc[ai][bj][m][n]; *(f32x4*)p = v;
                    }
            }
    }
};

template <class Epi> DI void run_gemm(LAS unsigned char* lds, const bf16_t* A, int lda, const bf16_t* Bt, int ldb, int N, int K, const Epi& E, int tid) {
    pg8::Gemm g{A, Bt, lda, ldb, M_ALL, N, K}; pg8::StaticOrder S; S.init(M_ALL, N, (int)gridDim.x, (int)blockIdx.x);
    pg8::gemm_phase<Epi, pg8::StaticOrder, true, true>(lds, g, S, E, tid);
}

DI void titem(const float* W, int N, bf16_t* dst, int ldt, int nrow0, int kcol0, const float* ks, int kb, int nb, LAS float* scr, int lane) {
    const int k0 = 64 * kb, n0 = 32 * nb;
    const int c = lane & 7;
    if (W) {
#pragma unroll 8
        for (int i = 0; i < 32; ++i) { const int kk = 2 * i + (lane >> 5); float w = W[(size_t)(k0 + kk) * N + n0 + (lane & 31)]; if (ks) w *= ks[k0 + kk]; scr[kk * 33 + (lane & 31)] = w; }
        asm volatile("s_waitcnt lgkmcnt(0)" ::: "memory");
#pragma unroll
        for (int j = 0; j < 4; ++j) { const int n = (lane >> 3) + 8 * j; const LAS float* s = scr + (8 * c) * 33 + n;
            u32x4 o; o.x = cvtpk(s[0 * 33], s[1 * 33]); o.y = cvtpk(s[2 * 33], s[3 * 33]); o.z = cvtpk(s[4 * 33], s[5 * 33]); o.w = cvtpk(s[6 * 33], s[7 * 33]);
            *(u32x4*)(dst + (size_t)(nrow0 + n0 + n) * ldt + kcol0 + k0 + 8 * c) = o; }
        asm volatile("s_waitcnt lgkmcnt(0)" ::: "memory");
    } else {
#pragma unroll
        for (int j = 0; j < 4; ++j) { const int n = (lane >> 3) + 8 * j; *(u32x4*)(dst + (size_t)(nrow0 + n0 + n) * ldt + kcol0 + k0 + 8 * c) = (u32x4){0u, 0u, 0u, 0u}; }
    }
}
struct WaveCtx { int gw, ngw, lane; LAS float* scr; };
DI void tmat(const WaveCtx& w, int& itbase, const float* W, int K, int N, bf16_t* dst, int ldt, int nrow0, int kcol0, const float* ks) {
    const int nblk = N / 32, nit = (K / 64) * nblk;
    int first = (w.gw - itbase % w.ngw + w.ngw) % w.ngw;
    for (int it = first; it < nit; it += w.ngw) titem(W, N, dst, ldt, nrow0, kcol0, ks, it / nblk, it % nblk, w.scr, w.lane);
    itbase += nit;
}
DI void tzero(const WaveCtx& w, int& itbase, int K, int N, bf16_t* dst, int ldt, int nrow0, int kcol0) {
    const int nblk = N / 32, nit = (K / 64) * nblk;
    int first = (w.gw - itbase % w.ngw + w.ngw) % w.ngw;
    for (int it = first; it < nit; it += w.ngw) titem(nullptr, N, dst, ldt, nrow0, kcol0, nullptr, it / nblk, it % nblk, w.scr, w.lane);
    itbase += nit;
}

DI void convert_mixer_weights(KP p, const WaveCtx& w, int layer) {
    const int kind = layer % 3, j = layer / 3; unsigned char* ws = p->ws; int ib = 0;
    if (kind == 0) {
        tmat(w, ib, p->in[13] + (size_t)j * D * 3072, D, 3072, (bf16_t*)(ws + WS_WQKVT), D, 0, 0, nullptr);
        tmat(w, ib, p->in[18] + (size_t)j * D * D, D, D, (bf16_t*)(ws + WS_WOT), D, 0, 0, nullptr);
    } else if (kind == 2) {
        tmat(w, ib, p->in[35], D, 1536, (bf16_t*)(ws + WS_WQKVT), D, 0, 0, nullptr);
        tmat(w, ib, p->in[39], D, D, (bf16_t*)(ws + WS_WOT), D, 0, 0, nullptr);
    } else {
        bf16_t* s1 = (bf16_t*)(ws + WS_S1T); const float* mu = p->in[19];
        for (int m = 0; m < 3; ++m) {
            tmat(w, ib, p->in[20] + (size_t)m * D * D, D, D, s1, 2048, m * 1024, 0, nullptr);
            tmat(w, ib, p->in[20] + (size_t)m * D * D, D, D, s1, 2048, m * 1024, 1024, mu + m * D);
        }
        for (int d = 0; d < 2; ++d) {
            tmat(w, ib, p->in[22] + (size_t)d * D * 64, D, 64, s1, 2048, 3072 + d * 64, 0, nullptr);
            tmat(w, ib, p->in[22] + (size_t)d * D * 64, D, 64, s1, 2048, 3072 + d * 64, 1024, mu + 3 * D);
            tmat(w, ib, p->in[25] + (size_t)d * D * 64, D, 64, s1, 2048, 3200 + d * 64, 0, nullptr);
            tmat(w, ib, p->in[25] + (size_t)d * D * 64, D, 64, s1, 2048, 3200 + d * 64, 1024, mu + 4 * D);
        }
        tmat(w, ib, p->in[27], D, 128, s1, 2048, 3328, 0, nullptr);
        tmat(w, ib, p->in[27], D, 128, s1, 2048, 3328, 1024, mu + 5 * D);
        tzero(w, ib, 2048, 128, s1, 2048, 3456, 0);
        bf16_t* s2 = (bf16_t*)(ws + WS_S2T);
        for (int rg = 0; rg < 4; ++rg)
            for (int kb = 0; kb < 4; ++kb) {
                if (kb == rg) tmat(w, ib, (rg < 2 ? p->in[23] : p->in[26]) + (size_t)(rg & 1) * 64 * D, 64, D, s2, 256, rg * 1024, kb * 64, nullptr);
                else tzero(w, ib, 64, D, s2, 256, rg * 1024, kb * 64);
            }
        bf16_t* g2 = (bf16_t*)(ws + WS_G2T);
        tmat(w, ib, p->in[28], 128, D, g2, 256, 0, 0, nullptr);
        tzero(w, ib, 128, D, g2, 256, 0, 128);
        tmat(w, ib, p->in[34], D, D, (bf16_t*)(ws + WS_RWO), D, 0, 0, nullptr);
    }
}
DI void convert_mlp_weights(KP p, const WaveCtx& w, int layer) {
    int ib = 0;
    tmat(w, ib, p->in[11] + (size_t)layer * D * FFD, D, FFD, (bf16_t*)(p->ws + WS_W1T), D, 0, 0, nullptr);
    tmat(w, ib, p->in[12] + (size_t)layer * D * FFD, FFD, D, (bf16_t*)(p->ws + WS_W2T), FFD, 0, 0, nullptr);
}

DI void phase_mod(KP p, LAS unsigned char* lds, const int tid) {
    LAS float* sl = (LAS float*)lds;
    LAS float* red = sl + 3 * 1024;
    for (int i = tid; i < 3 * 1024; i += 512) { const int c = i >> 10, k = i & 1023; const float v = (c == 0) ? p->in[8][k] : p->in[7][(c - 1) * 1024 + k]; sl[i] = v / (1.f + __expf(-v)); }
    __syncthreads();
    float* mod = (float*)(p->ws + WS_MOD);
    const int cg_ = tid & 63, kg = tid >> 6;
    for (int unit = blockIdx.x; unit < 4 * 96; unit += gridDim.x) {
        const int l = unit / 96, c0 = (unit % 96) * 64;
        const float* W = p->in[9] + (size_t)l * D * MODW + c0 + cg_;
        float a0 = 0.f, a1 = 0.f, a2 = 0.f;
#pragma unroll 8
        for (int k = kg * 128; k < kg * 128 + 128; ++k) { const float wv = W[(size_t)k * MODW]; a0 += sl[k] * wv; a1 += sl[1024 + k] * wv; a2 += sl[2048 + k] * wv; }
        red[(kg * 3 + 0) * 64 + cg_] = a0; red[(kg * 3 + 1) * 64 + cg_] = a1; red[(kg * 3 + 2) * 64 + cg_] = a2;
        __syncthreads();
        if (tid < 192) { const int c = tid >> 6; float s = p->in[10][l * MODW + c0 + cg_];
#pragma unroll
            for (int q = 0; q < 8; ++q) s += red[(q * 3 + c) * 64 + cg_];
            mod[(size_t)(l * 3 + c) * MODW + c0 + cg_] = s; }
        __syncthreads();
    }
    float* rc = (float*)(p->ws + WS_ROPE); float* rs = rc + 2048 * 32;
    for (int i = blockIdx.x * 512 + tid; i < 2048 * 32; i += gridDim.x * 512) {
        const int t = i >> 5, jj = i & 31; const int pos = (jj < 16) ? (t >> 6) : (t & 63); const int f = jj & 15;
        const float inv = __builtin_amdgcn_exp2f(-(float)f * (13.287712379549449f / 16.f)); const float ang = (float)pos * inv;
        const float kq = rintf(ang * 0.15915494309189535f); float rr = fmaf(-kq, 6.2831855f, ang); rr = fmaf(-kq, -1.7484555e-7f, rr);
        rc[i] = __cosf(rr); rs[i] = __sinf(rr);
    }
}

DI void norm_row(const float* xr, const float* sc, const float* sh, int lane, f32x4 (&h)[4], bool valid) {
    const f32x4* x4 = (const f32x4*)xr + lane; float ss = 0.f;
#pragma unroll
    for (int j = 0; j < 4; ++j) { h[j] = valid ? x4[64 * j] : (f32x4){0.f, 0.f, 0.f, 0.f}; ss += (h[j].x * h[j].x + h[j].y * h[j].y) + (h[j].z * h[j].z + h[j].w * h[j].w); }
    const float rstd = rsqrtf(wave_sum(ss) * (1.f / D) + 1e-6f);
    const f32x4* sc4 = (const f32x4*)sc + lane; const f32x4* sh4 = (const f32x4*)sh + lane;
#pragma unroll
    for (int j = 0; j < 4; ++j) { const f32x4 s = sc4[64 * j], b = sh4[64 * j]; h[j] = valid ? (h[j] * rstd * (1.f + s) + b) : (f32x4){0.f, 0.f, 0.f, 0.f}; }
}
DI const float* xrow_ptr(KP p, int row, bool from_input) {
    if (from_input) return row < M_CTX ? p->in[0] + (size_t)row * D : p->in[1] + (size_t)(row - M_CTX) * D;
    return p->out + O_X + (size_t)row * D;
}
DI void phase_norm(KP p, const WaveCtx& w, int layer, int which) {
    const float* mod = (const float*)(p->ws + WS_MOD) + (size_t)layer * 3 * MODW;
    bf16_t* H = (bf16_t*)(p->ws + WS_A);
    const bool from_in = (layer == 0 && which == 0);
    for (int row = w.gw; row < M_ALL; row += w.ngw) {
        const float* mc = mod + cond_of_row(row) * MODW + which * 3 * D;
        const float* xr = xrow_ptr(p, row, from_in);
        f32x4 h[4];
        if (from_in) { const f32x4* x4 = (const f32x4*)xr + w.lane; f32x4* o4 = (f32x4*)(p->out + O_X + (size_t)row * D) + w.lane;
#pragma unroll
            for (int j = 0; j < 4; ++j) o4[64 * j] = x4[64 * j]; }
        norm_row(xr, mc + D, mc, w.lane, h, true);
        u32x2* o = (u32x2*)(H + (size_t)row * D) + w.lane;
#pragma unroll
        for (int j = 0; j < 4; ++j) { u32x2 v; v.x = cvtpk(h[j].x, h[j].y); v.y = cvtpk(h[j].z, h[j].w); o[64 * j] = v; }
    }
}
DI void phase_norm_rwkv(KP p, const WaveCtx& w, int layer) {
    const float* mod = (const float*)(p->ws + WS_MOD) + (size_t)layer * 3 * MODW;
    bf16_t* A2 = (bf16_t*)(p->ws + WS_A);
    for (int row = w.gw; row < M_ALL; row += w.ngw) {
        const float* mc = mod + cond_of_row(row) * MODW;
        int t, T; if (row < M_CTX) { t = row & 255; T = T_CTX; } else { t = (row - M_CTX) & 2047; T = T_LAT; }
        const float* xr = p->out + O_X + (size_t)row * D;
        f32x4 hc[4], hp[4], hn[4];
        norm_row(xr, mc + D, mc, w.lane, hc, true);
        norm_row(xr - D, mc + D, mc, w.lane, hp, t > 0);
        norm_row(t < T - 1 ? xr + D : xr, mc + D, mc, w.lane, hn, t < T - 1);
        u32x2* o = (u32x2*)(A2 + (size_t)row * 2048) + w.lane;
#pragma unroll
        for (int j = 0; j < 4; ++j) {
            u32x2 v; v.x = cvtpk(hc[j].x, hc[j].y); v.y = cvtpk(hc[j].z, hc[j].w); o[64 * j] = v;
            const f32x4 xx = 0.5f * (hp[j] + hn[j]) - hc[j];
            u32x2 q; q.x = cvtpk(xx.x, xx.y); q.y = cvtpk(xx.z, xx.w); o[256 + 64 * j] = q;
        }
    }
}

struct AttnCfg {
    int ldq;
    int nq, nk;
    int vw;
    int dv, nvh;
    int kl, j;
    const float *qn, *kn;
    float *kout, *vout;
    const float *ck, *cv;
};
DI AttnCfg make_cfg(KP p, int kind, int j) {
    AttnCfg c;
    if (kind == 0) { c.ldq = 3072; c.nq = 16; c.nk = 16; c.vw = 1024; c.dv = 128; c.nvh = 8; c.kl = 2; c.j = j; c.qn = p->in[14] + j * 64; c.kn = p->in[15] + j * 64;
        c.kout = p->out + O_DAK; c.vout = p->out + O_DAV; c.ck = p->in[2]; c.cv = p->in[3]; }
    else { c.ldq = 1536; c.nq = 16; c.nk = 4; c.vw = 256; c.dv = 64; c.nvh = 4; c.kl = 1; c.j = 0; c.qn = p->in[36]; c.kn = p->in[37];
        c.kout = p->out + O_SWK; c.vout = p->out + O_SWV; c.ck = p->in[5]; c.cv = p->in[6]; }
    return c;
}

DI void phase_qkprep(KP p, const WaveCtx& w, const AttnCfg& c, LAS unsigned char* lds_wave) {
    bf16_t* QKV = (bf16_t*)(p->ws + WS_QKV);
    const float* rc = (const float*)(p->ws + WS_ROPE); const float* rs = rc + 2048 * 32;
    const int lane = w.lane, g = lane >> 1, half = lane & 1;
    const int ng = c.nq + c.nk;
    for (int row = w.gw; row < M_ALL; row += w.ngw) {
        const bool lat = row >= M_CTX; const int tl = lat ? ((row - M_CTX) & 2047) : 0;
        const int b = row >> 8, t = row & 255;
        if (g < ng) {
            const bool isq = g < c.nq;
            const int col = (isq ? g * 64 : 1024 + (g - c.nq) * 64) + half * 32;
            bf16_t* src = QKV + (size_t)row * c.ldq + col;
            float v[32]; float ss = 0.f;
#pragma unroll
            for (int q4 = 0; q4 < 4; ++q4) { const u32x4 wv = *(const u32x4*)(src + 8 * q4); float f[8]; unpack8(wv, f);
#pragma unroll
                for (int e = 0; e < 8; ++e) { v[8 * q4 + e] = f[e]; ss += f[e] * f[e]; } }
            ss = sum2(ss);
            const float rstd = rsqrtf(ss * (1.f / 64.f) + 1e-6f);
            const float* gn = (isq ? c.qn : c.kn) + half * 32;
#pragma unroll
            for (int e = 0; e < 32; ++e) v[e] = v[e] * rstd * gn[e];
            if (lat) {
                const float* cp = rc + tl * 32; const float* sp = rs + tl * 32;
#pragma unroll
                for (int e = 0; e < 32; ++e) { const float pr = dpp_mov<0xB1>(v[e]); const float cs = cp[e], sn = sp[e]; v[e] = half ? (v[e] * cs + pr * sn) : (v[e] * cs - pr * sn); }
            }
            if (!isq && !lat) {
                float* ko = c.kout + ((size_t)(b * c.kl + c.j) * 256 + t) * (c.nk * 64) + (g - c.nq) * 64 + half * 32;
#pragma unroll
                for (int q4 = 0; q4 < 8; ++q4) *(f32x4*)(ko + 4 * q4) = (f32x4){v[4 * q4], v[4 * q4 + 1], v[4 * q4 + 2], v[4 * q4 + 3]};
            }
            const float qs = isq ? QSCALE : 1.f;
#pragma unroll
            for (int q4 = 0; q4 < 4; ++q4) { float f[8];
#pragma unroll
                for (int e = 0; e < 8; ++e) f[e] = v[8 * q4 + e] * qs;
                *(u32x4*)(src + 8 * q4) = pack8(f); }
        }
        if (!lat) {
            const bf16_t* vs = QKV + (size_t)row * c.ldq + 1024 + c.nk * 64;
            float* vo = c.vout + ((size_t)(b * c.kl + c.j) * 256 + t) * c.vw;
            for (int i = lane * 4; i < c.vw; i += 256) { const u32x2 wv = *(const u32x2*)(vs + i); *(f32x4*)(vo + i) = (f32x4){bflo(wv.x), bfhi(wv.x), bflo(wv.y), bfhi(wv.y)}; }
        }
    }
    {
        const int kw = c.nk * 64; bf16_t* Kc = (bf16_t*)(p->ws + WS_KC);
        const int n8 = 2 * 256 * kw / 8;
        for (int i = w.gw * 64 + lane; i < n8; i += w.ngw * 64) {
            const int r = (i * 8) / kw, cc = (i * 8) % kw; const int b = r >> 8, t = r & 255;
            const float* s = c.ck + ((size_t)(b * c.kl + c.j) * 256 + t) * kw + cc;
            const f32x4 a = *(const f32x4*)s, bq = *(const f32x4*)(s + 4);
            u32x4 o; o.x = cvtpk(a.x, a.y); o.y = cvtpk(a.z, a.w); o.z = cvtpk(bq.x, bq.y); o.w = cvtpk(bq.z, bq.w);
            *(u32x4*)(Kc + (size_t)r * kw + cc) = o;
        }
    }
    {
        LAS bf16_t* T = (LAS bf16_t*)lds_wave; const int pitch = c.dv + 2;
        bf16_t* VtC = (bf16_t*)(p->ws + WS_VTC); bf16_t* VtL = (bf16_t*)(p->ws + WS_VTL);
        const int n_ctx = 32 * 8 * c.nvh, n_lat = 2 * 64 * c.nvh, n_cache = 2 * 8 * c.nvh, ntile = n_ctx + n_lat + n_cache;
        const int cpr = c.dv / 8;
        for (int tile = w.gw; tile < ntile; tile += w.ngw) {
            int vh, blk, seq, kindt; int r = tile;
            if (r < n_ctx) { kindt = 0; vh = r % c.nvh; r /= c.nvh; blk = r % 8; seq = r / 8; }
            else if (r < n_ctx + n_lat) { r -= n_ctx; kindt = 1; vh = r % c.nvh; r /= c.nvh; blk = r % 64; seq = r / 64; }
            else { r -= n_ctx + n_lat; kindt = 2; vh = r % c.nvh; r /= c.nvh; blk = r % 8; seq = r / 8; }
            for (int ch = lane; ch < 32 * cpr; ch += 64) {
                const int tr = ch / cpr, cc = (ch % cpr) * 8; u32x4 wv;
                if (kindt == 2) { const float* s = c.cv + ((size_t)(seq * c.kl + c.j) * 256 + blk * 32 + tr) * c.vw + vh * c.dv + cc;
                    const f32x4 a = *(const f32x4*)s, bq = *(const f32x4*)(s + 4); wv.x = cvtpk(a.x, a.y); wv.y = cvtpk(a.z, a.w); wv.z = cvtpk(bq.x, bq.y); wv.w = cvtpk(bq.z, bq.w); }
                else { const int row = (kindt == 0 ? seq * 256 : M_CTX + seq * 2048) + blk * 32 + tr;
                    wv = *(const u32x4*)(QKV + (size_t)row * c.ldq + 1024 + c.nk * 64 + vh * c.dv + cc); }
                LAS unsigned* d = (LAS unsigned*)(T + tr * pitch + cc);
                d[0] = wv.x; d[1] = wv.y; d[2] = wv.z; d[3] = wv.w;
            }
            asm volatile("s_waitcnt lgkmcnt(0)" ::: "memory");
            bf16_t* dst; int ldv;
            if (kindt == 0) { dst = VtC + (size_t)((seq * c.nvh + vh) * c.dv) * 256 + blk * 32; ldv = 256; }
            else { dst = VtL + (size_t)((seq * c.nvh + vh) * c.dv) * 2304 + (kindt == 1 ? 256 : 0) + blk * 32; ldv = 2304; }
            for (int id = lane; id < c.dv * 4; id += 64) {
                const int d = id >> 2, cch = id & 3, sl = cch >> 1, hi = cch & 1;
                unsigned short e[8];
#pragma unroll
                for (int q = 0; q < 8; ++q) { const int kv = 16 * sl + 8 * (q >> 2) + 4 * hi + (q & 3); e[q] = T[kv * pitch + d]; }
                u32x4 o; o.x = e[0] | ((unsigned)e[1] << 16); o.y = e[2] | ((unsigned)e[3] << 16); o.z = e[4] | ((unsigned)e[5] << 16); o.w = e[6] | ((unsigned)e[7] << 16);
                *(u32x4*)(dst + (size_t)d * ldv + cch * 8) = o;
            }
            asm volatile("s_waitcnt lgkmcnt(0)" ::: "memory");
        }
    }
}

#define MFMA32(a, b, c) __builtin_amdgcn_mfma_f32_32x32x16_bf16((a), (b), (c), 0, 0, 0)
DI int crow(int r, int hi) { return (r & 3) + 8 * (r >> 2) + 4 * hi; }

template <int NDT, bool MASK>
DI void attn_seg(f32x16 (&o)[NDT], float& m, float& l, const bf16x8 (&qr)[4], const bf16_t* K, int ldk, const bf16_t* Vt, int ldv, int ntiles, int r32, int hi, int qpos, int kpos0) {
    for (int t = 0; t < ntiles; ++t) {
        const bf16_t* kp = K + (size_t)(t * 32 + r32) * ldk + 8 * hi;
        bf16x8 kf[4];
#pragma unroll
        for (int d0 = 0; d0 < 4; ++d0) kf[d0] = *(const bf16x8*)(kp + 16 * d0);
        f32x16 pr;
#pragma unroll
        for (int r = 0; r < 16; ++r) pr[r] = 0.f;
#pragma unroll
        for (int d0 = 0; d0 < 4; ++d0) pr = MFMA32(kf[d0], qr[d0], pr);
        if (MASK) {
#pragma unroll
            for (int r = 0; r < 16; ++r) { const int dl = kpos0 + t * 32 + crow(r, hi) - qpos; if (dl > 128 || dl < -128) pr[r] = -1e30f; }
        }
        float mx = pr[0];
#pragma unroll
        for (int r = 1; r < 16; ++r) mx = fmaxf(mx, pr[r]);
        mx = fmaxf(mx, __shfl_xor(mx, 32));
        const float mn = fmaxf(m, mx);
        const float alpha = __builtin_amdgcn_exp2f(m - mn);
        m = mn;
        float rsum = 0.f;
#pragma unroll
        for (int r = 0; r < 16; ++r) { pr[r] = __builtin_amdgcn_exp2f(pr[r] - mn); rsum += pr[r]; }
        l = l * alpha + rsum;
#pragma unroll
        for (int dt = 0; dt < NDT; ++dt)
#pragma unroll
            for (int r = 0; r < 16; ++r) o[dt][r] *= alpha;
        bf16x8 pb[2];
#pragma unroll
        for (int s = 0; s < 2; ++s) { u32x4 wv; wv.x = cvtpk(pr[8 * s], pr[8 * s + 1]); wv.y = cvtpk(pr[8 * s + 2], pr[8 * s + 3]); wv.z = cvtpk(pr[8 * s + 4], pr[8 * s + 5]); wv.w = cvtpk(pr[8 * s + 6], pr[8 * s + 7]); pb[s] = __builtin_bit_cast(bf16x8, wv); }
#pragma unroll
        for (int dt = 0; dt < NDT; ++dt) {
            const bf16_t* vp = Vt + (size_t)(dt * 32 + r32) * ldv + t * 32 + hi * 8;
            const bf16x8 v0 = *(const bf16x8*)(vp), v1 = *(const bf16x8*)(vp + 16);
            o[dt] = MFMA32(v0, pb[0], o[dt]); o[dt] = MFMA32(v1, pb[1], o[dt]);
        }
    }
}
DI void load_q(bf16x8 (&qr)[4], const bf16_t* Q, int ldq, int r32, int hi) {
#pragma unroll
    for (int d0 = 0; d0 < 4; ++d0) qr[d0] = *(const bf16x8*)(Q + (size_t)r32 * ldq + 16 * d0 + 8 * hi);
}
template <int NDT> DI void zero_o(f32x16 (&o)[NDT]) {
#pragma unroll
    for (int dt = 0; dt < NDT; ++dt)
#pragma unroll
        for (int r = 0; r < 16; ++r) o[dt][r] = 0.f;
}

DI void da_unit(KP p, int layer, bool is_lat, int b, int h, int qb, int lane, float lam, float lam_init, LAS float* osm) {
    const int j = layer / 3;
    const bf16_t* QKV = (const bf16_t*)(p->ws + WS_QKV); const bf16_t* Kc = (const bf16_t*)(p->ws + WS_KC);
    const bf16_t* VtC = (const bf16_t*)(p->ws + WS_VTC); const bf16_t* VtL = (const bf16_t*)(p->ws + WS_VTL);
    bf16_t* AO = (bf16_t*)(p->ws + WS_AO);
    const int r32 = lane & 31, hi = lane >> 5;
    const int row0 = (is_lat ? M_CTX + b * 2048 : b * 256) + qb * 32;
    const int seq0 = is_lat ? M_CTX + b * 2048 : b * 256;
    f32x16 o2[4];
    for (int mp = 0; mp < 2; ++mp) {
        bf16x8 qr[4]; load_q(qr, QKV + (size_t)row0 * 3072 + h * 128 + mp * 64, 3072, r32, hi);
        float m = -1e30f, l = 0.f; zero_o<4>(o2);
        if (is_lat) {
            const bf16_t* vt = VtL + (size_t)((b * 8 + h) * 128) * 2304;
            attn_seg<4, false>(o2, m, l, qr, Kc + (size_t)(b * 256) * 1024 + h * 128 + mp * 64, 1024, vt, 2304, 8, r32, hi, 0, 0);
            attn_seg<4, false>(o2, m, l, qr, QKV + (size_t)seq0 * 3072 + 1024 + h * 128 + mp * 64, 3072, vt + 256, 2304, 64, r32, hi, 0, 0);
        } else {
            attn_seg<4, false>(o2, m, l, qr, QKV + (size_t)seq0 * 3072 + 1024 + h * 128 + mp * 64, 3072, VtC + (size_t)((b * 8 + h) * 128) * 256, 256, 8, r32, hi, 0, 0);
        }
        l += __shfl_xor(l, 32);
        const float il = 1.f / l;
        if (mp == 0) {
#pragma unroll
            for (int dt = 0; dt < 4; ++dt)
#pragma unroll
                for (int r = 0; r < 16; ++r) osm[(dt * 16 + r) * 64 + lane] = o2[dt][r] * il;
        } else {
#pragma unroll
            for (int dt = 0; dt < 4; ++dt)
#pragma unroll
                for (int r = 0; r < 16; ++r) o2[dt][r] = osm[(dt * 16 + r) * 64 + lane] - lam * o2[dt][r] * il;
        }
    }
    f32x16 (&o1)[4] = o2;
    float ss = 0.f;
#pragma unroll
    for (int dt = 0; dt < 4; ++dt)
#pragma unroll
        for (int r = 0; r < 16; ++r) ss += o1[dt][r] * o1[dt][r];
    ss += __shfl_xor(ss, 32);
    const float sc = rsqrtf(ss * (1.f / 128.f) + 1e-6f) * (1.f - lam_init);
    const float* sg = p->in[17] + j * 128;
    bf16_t* orow = AO + (size_t)(row0 + r32) * D + h * 128;
#pragma unroll
    for (int dt = 0; dt < 4; ++dt)
#pragma unroll
        for (int k4 = 0; k4 < 4; ++k4) {
            const int d = dt * 32 + 8 * k4 + 4 * hi; const f32x4 gq = *(const f32x4*)(sg + d);
            u32x2 wv; wv.x = cvtpk(o1[dt][4 * k4] * sc * gq.x, o1[dt][4 * k4 + 1] * sc * gq.y); wv.y = cvtpk(o1[dt][4 * k4 + 2] * sc * gq.z, o1[dt][4 * k4 + 3] * sc * gq.w);
            *(u32x2*)(orow + d) = wv;
        }
}
DI void phase_attn_da(KP p, int layer, int wave, int lane, LAS float* osm) {
    const int j = layer / 3;
    const float* lp = p->in[16] + j * 256;
    const float s1 = wave_sum(lp[lane] * lp[64 + lane]), s2 = wave_sum(lp[128 + lane] * lp[192 + lane]);
    const float lam_init = 0.8f - 0.6f * expf(-0.3f * (float)layer);
    const float lam = expf(s1) - expf(s2) + lam_init;
    const int G = gridDim.x;
    if (wave < 4) {
        for (int u = blockIdx.x * 4 + wave; u < 1024; u += G * 4) { const int qb = u & 63, bh = u >> 6; da_unit(p, layer, true, bh >> 3, bh & 7, qb, lane, lam, lam_init, osm); }
    } else {
        for (int u = blockIdx.x * 4 + (wave - 4); u < 2048; u += G * 4) {
            const int bh = u >> 3, qb = u & 7;
            da_unit(p, layer, false, bh >> 3, bh & 7, qb, lane, lam, lam_init, osm);
        }
    }
}

DI void swa_unit(KP p, bool is_lat, int b, int qh, int qb, int lane) {
    const bf16_t* QKV = (const bf16_t*)(p->ws + WS_QKV); const bf16_t* Kc = (const bf16_t*)(p->ws + WS_KC);
    const bf16_t* VtC = (const bf16_t*)(p->ws + WS_VTC); const bf16_t* VtL = (const bf16_t*)(p->ws + WS_VTL);
    bf16_t* AO = (bf16_t*)(p->ws + WS_AO);
    const int r32 = lane & 31, hi = lane >> 5, kvh = qh >> 2;
    const int seq0 = is_lat ? M_CTX + b * 2048 : b * 256;
    const int row0 = seq0 + qb * 32;
    bf16x8 qr[4]; load_q(qr, QKV + (size_t)row0 * 1536 + qh * 64, 1536, r32, hi);
    f32x16 o[2]; zero_o<2>(o); float m = -1e30f, l = 0.f;
    if (is_lat) {
        const bf16_t* vt = VtL + (size_t)((b * 4 + kvh) * 64) * 2304;
        attn_seg<2, false>(o, m, l, qr, Kc + (size_t)(b * 256) * 256 + kvh * 64, 256, vt, 2304, 8, r32, hi, 0, 0);
        const int q0 = qb * 32; int t0 = q0 - 128; if (t0 < 0) t0 = 0; int t1 = q0 + 160; if (t1 > 2048) t1 = 2048;
        attn_seg<2, true>(o, m, l, qr, QKV + (size_t)(seq0 + t0) * 1536 + 1024 + kvh * 64, 1536, vt + 256 + t0, 2304, (t1 - t0) >> 5, r32, hi, q0 + r32, t0);
    } else {
        attn_seg<2, false>(o, m, l, qr, QKV + (size_t)seq0 * 1536 + 1024 + kvh * 64, 1536, VtC + (size_t)((b * 4 + kvh) * 64) * 256, 256, 8, r32, hi, 0, 0);
    }
    l += __shfl_xor(l, 32);
    l += __builtin_amdgcn_exp2f(p->in[38][qh] * LOG2E - m);
    const float il = 1.f / l;
    bf16_t* orow = AO + (size_t)(row0 + r32) * D + qh * 64;
#pragma unroll
    for (int dt = 0; dt < 2; ++dt)
#pragma unroll
        for (int k4 = 0; k4 < 4; ++k4) {
            const int d = dt * 32 + 8 * k4 + 4 * hi;
            u32x2 wv; wv.x = cvtpk(o[dt][4 * k4] * il, o[dt][4 * k4 + 1] * il); wv.y = cvtpk(o[dt][4 * k4 + 2] * il, o[dt][4 * k4 + 3] * il);
            *(u32x2*)(orow + d) = wv;
        }
}
DI void phase_attn_swa(KP p, int wave, int lane) {
    const int G = gridDim.x;
    for (int u = blockIdx.x * 8 + wave; u < 2048; u += G * 8) { const int qb = u & 63, bq = u >> 6; swa_unit(p, true, bq >> 4, bq & 15, qb, lane); }
    for (int u = blockIdx.x * 8 + wave; u < 4096; u += G * 8) { const int qb = u & 7, bq = u >> 3; swa_unit(p, false, bq >> 4, bq & 15, qb, lane); }
}

struct ScanRun {
    int row0;
    int h, dir;
    int t_first;
    int nsteps;
    int kind;
    const float* init;
    int init_ident;
    bf16_t* yout;
    float* fin;
};
DI void scan_run(KP p, const ScanRun& R, LAS float* sm, int lane) {
    const bf16_t* RKV = (const bf16_t*)(p->ws + WS_B);
    const bf16_t* E = (const bf16_t*)(p->ws + WS_E) + (size_t)R.dir * M_ALL * D;
    const bf16_t* AA = (const bf16_t*)(p->ws + WS_AA) + (size_t)R.dir * M_ALL * D;
    const int rg = lane >> 3, ks = lane & 7;
    const int st = lane >> 3, cs = lane & 7;
    const int hc = R.h * 64 + cs * 8;
    float kkw[8], kaw[8];
#pragma unroll
    for (int e = 0; e < 8; ++e) { kkw[e] = p->in[29][hc + e]; kaw[e] = p->in[30][hc + e]; }
    f32x2 s[8][4];
#pragma unroll
    for (int i = 0; i < 8; ++i)
#pragma unroll
        for (int q = 0; q < 4; ++q) {
            f32x2 v = {0.f, 0.f};
            if (R.init) v = *(const f32x2*)(R.init + (8 * rg + i) * 64 + 8 * ks + 2 * q);
            else if (R.init_ident) { v.x = (8 * rg + i == 8 * ks + 2 * q) ? 1.f : 0.f; v.y = (8 * rg + i == 8 * ks + 2 * q + 1) ? 1.f : 0.f; }
            s[i][q] = v;
        }
    const int sgn = R.dir ? -1 : 1;
    const int nch = R.nsteps >> 3;
    u32x4 gr, gk, gv, ge, ga;
    auto issue = [&](int c) {
        const int t = R.t_first + sgn * (c * 8 + st);
        const size_t row = (size_t)(R.row0 + t);
        gr = *(const u32x4*)(RKV + row * 3072 + hc); gk = *(const u32x4*)(RKV + row * 3072 + 1024 + hc); gv = *(const u32x4*)(RKV + row * 3072 + 2048 + hc);
        ge = *(const u32x4*)(E + row * D + hc); ga = *(const u32x4*)(AA + row * D + hc);
    };
    issue(0);
    for (int c = 0; c < nch; ++c) {
        {
            float fr[8], fk[8], fv[8], fe[8], fa[8];
            unpack8(gr, fr); unpack8(gk, fk); unpack8(gv, fv); unpack8(ge, fe); unpack8(ga, fa);
            float ss = 0.f; float kk[8];
#pragma unroll
            for (int e = 0; e < 8; ++e) { kk[e] = fk[e] * kkw[e]; ss += kk[e] * kk[e]; }
            ss = sum8(ss);
            const float rn = rsqrtf(fmaxf(ss, 1e-24f));
            LAS float* d = sm + st * 384 + cs * 8;
            f32x4 o0, o1;
#pragma unroll
            for (int e = 0; e < 8; ++e) kk[e] *= rn;
            o0 = (f32x4){-kk[0], -kk[1], -kk[2], -kk[3]}; o1 = (f32x4){-kk[4], -kk[5], -kk[6], -kk[7]}; *(LAS f32x4*)(d) = o0; *(LAS f32x4*)(d + 4) = o1;
            float wv[8];
#pragma unroll
            for (int e = 0; e < 8; ++e) wv[e] = __expf(-fe[e]);
            o0 = (f32x4){wv[0], wv[1], wv[2], wv[3]}; o1 = (f32x4){wv[4], wv[5], wv[6], wv[7]}; *(LAS f32x4*)(d + 64) = o0; *(LAS f32x4*)(d + 68) = o1;
            o0 = (f32x4){kk[0] * fa[0], kk[1] * fa[1], kk[2] * fa[2], kk[3] * fa[3]}; o1 = (f32x4){kk[4] * fa[4], kk[5] * fa[5], kk[6] * fa[6], kk[7] * fa[7]}; *(LAS f32x4*)(d + 128) = o0; *(LAS f32x4*)(d + 132) = o1;
            float kd[8];
#pragma unroll
            for (int e = 0; e < 8; ++e) kd[e] = fk[e] * (1.f + (fa[e] - 1.f) * kaw[e]);
            o0 = (f32x4){kd[0], kd[1], kd[2], kd[3]}; o1 = (f32x4){kd[4], kd[5], kd[6], kd[7]}; *(LAS f32x4*)(d + 192) = o0; *(LAS f32x4*)(d + 196) = o1;
            o0 = (f32x4){fr[0], fr[1], fr[2], fr[3]}; o1 = (f32x4){fr[4], fr[5], fr[6], fr[7]}; *(LAS f32x4*)(d + 256) = o0; *(LAS f32x4*)(d + 260) = o1;
            if (R.kind == 1) { o0 = (f32x4){0.f, 0.f, 0.f, 0.f}; o1 = o0; } else { o0 = (f32x4){fv[0], fv[1], fv[2], fv[3]}; o1 = (f32x4){fv[4], fv[5], fv[6], fv[7]}; }
            *(LAS f32x4*)(d + 320) = o0; *(LAS f32x4*)(d + 324) = o1;
        }
        if (c + 1 < nch) issue(c + 1);
        asm volatile("s_waitcnt lgkmcnt(0)" ::: "memory");
#pragma unroll 2
        for (int q8 = 0; q8 < 8; ++q8) {
            const LAS float* b = sm + q8 * 384;
            f32x2 A[4], W[4], Bv[4], KD[4], Rr[4]; float V[8];
            { const f32x4 x0 = *(const LAS f32x4*)(b + 8 * ks), x1 = *(const LAS f32x4*)(b + 8 * ks + 4); A[0] = (f32x2){x0.x, x0.y}; A[1] = (f32x2){x0.z, x0.w}; A[2] = (f32x2){x1.x, x1.y}; A[3] = (f32x2){x1.z, x1.w}; }
            { const f32x4 x0 = *(const LAS f32x4*)(b + 64 + 8 * ks), x1 = *(const LAS f32x4*)(b + 64 + 8 * ks + 4); W[0] = (f32x2){x0.x, x0.y}; W[1] = (f32x2){x0.z, x0.w}; W[2] = (f32x2){x1.x, x1.y}; W[3] = (f32x2){x1.z, x1.w}; }
            { const f32x4 x0 = *(const LAS f32x4*)(b + 128 + 8 * ks), x1 = *(const LAS f32x4*)(b + 128 + 8 * ks + 4); Bv[0] = (f32x2){x0.x, x0.y}; Bv[1] = (f32x2){x0.z, x0.w}; Bv[2] = (f32x2){x1.x, x1.y}; Bv[3] = (f32x2){x1.z, x1.w}; }
            { const f32x4 x0 = *(const LAS f32x4*)(b + 192 + 8 * ks), x1 = *(const LAS f32x4*)(b + 192 + 8 * ks + 4); KD[0] = (f32x2){x0.x, x0.y}; KD[1] = (f32x2){x0.z, x0.w}; KD[2] = (f32x2){x1.x, x1.y}; KD[3] = (f32x2){x1.z, x1.w}; }
            { const f32x4 x0 = *(const LAS f32x4*)(b + 256 + 8 * ks), x1 = *(const LAS f32x4*)(b + 256 + 8 * ks + 4); Rr[0] = (f32x2){x0.x, x0.y}; Rr[1] = (f32x2){x0.z, x0.w}; Rr[2] = (f32x2){x1.x, x1.y}; Rr[3] = (f32x2){x1.z, x1.w}; }
            { const f32x4 x0 = *(const LAS f32x4*)(b + 320 + 8 * rg), x1 = *(const LAS f32x4*)(b + 320 + 8 * rg + 4); V[0] = x0.x; V[1] = x0.y; V[2] = x0.z; V[3] = x0.w; V[4] = x1.x; V[5] = x1.y; V[6] = x1.z; V[7] = x1.w; }
            float sa[8];
#pragma unroll
            for (int i = 0; i < 8; ++i) { f32x2 a2 = s[i][0] * A[0]; a2 += s[i][1] * A[1]; a2 += s[i][2] * A[2]; a2 += s[i][3] * A[3]; sa[i] = a2.x + a2.y; }
#pragma unroll
            for (int i = 0; i < 8; ++i) sa[i] = sum8(sa[i]);
            float y[8];
#pragma unroll
            for (int i = 0; i < 8; ++i) {
                const f32x2 sa2 = {sa[i], sa[i]}, v2 = {V[i], V[i]};
                f32x2 y2 = {0.f, 0.f};
#pragma unroll
                for (int q = 0; q < 4; ++q) { f32x2 tq = s[i][q] * W[q]; tq += sa2 * Bv[q]; tq += v2 * KD[q]; s[i][q] = tq; y2 += tq * Rr[q]; }
                y[i] = y2.x + y2.y;
            }
            if (R.yout) {
#pragma unroll
                for (int i = 0; i < 8; ++i) y[i] = sum8(y[i]);
                if (ks == 0) {
                    const int t = R.t_first + sgn * (c * 8 + q8);
                    *(u32x4*)(R.yout + (size_t)(R.row0 + t) * D + R.h * 64 + 8 * rg) = pack8(y);
                }
            }
        }
        asm volatile("s_waitcnt lgkmcnt(0)" ::: "memory");
    }
    if (R.fin) {
#pragma unroll
        for (int i = 0; i < 8; ++i) {
            float* fp = R.fin + (8 * rg + i) * 64 + 8 * ks;
            *(f32x4*)(fp) = (f32x4){s[i][0].x, s[i][0].y, s[i][1].x, s[i][1].y}; *(f32x4*)(fp + 4) = (f32x4){s[i][2].x, s[i][2].y, s[i][3].x, s[i][3].y};
        }
    }
}
constexpr int LSEG = 128, NSEG = 16;
DI void lat_scan_ids(int scan, int& b, int& h, int& dir) { b = scan >> 5; h = (scan >> 1) & 15; dir = scan & 1; }
DI void phase_scan1(KP p, LAS float* sm, int wave, int lane) {
    const int gw = blockIdx.x * 8 + wave;
    bf16_t* Y = (bf16_t*)(p->ws + WS_Y); float* SEGF = (float*)(p->ws + WS_SEGF);
    for (int slot = gw; slot < 2048; slot += gridDim.x * 8) {
        if (slot < 1024) {
            const int b = slot >> 5, h = (slot >> 1) & 15, dir = slot & 1;
            ScanRun R; R.row0 = b * 256; R.h = h; R.dir = dir; R.t_first = dir ? 255 : 0; R.nsteps = 256; R.kind = 0; R.init = nullptr; R.init_ident = 0;
            R.yout = Y + (size_t)dir * M_ALL * D; R.fin = p->out + O_RW + (size_t)((b * 2 + dir) * 16 + h) * 4096;
            scan_run(p, R, sm, lane);
        } else {
            for (int sub = 0; sub < 2; ++sub) {
                const int q = (slot - 1024) * 2 + sub; if (q >= 1984) break;
                int scan, seg, kind;
                if (q < 1024) { scan = q >> 4; seg = q & 15; kind = 0; } else { const int q2 = q - 1024; scan = q2 / 15; seg = 1 + q2 % 15; kind = 1; }
                int b, h, dir; lat_scan_ids(scan, b, h, dir);
                ScanRun R; R.row0 = M_CTX + b * 2048; R.h = h; R.dir = dir; R.t_first = dir ? (2047 - LSEG * seg) : LSEG * seg; R.nsteps = LSEG; R.kind = kind;
                R.init = (kind == 0 && seg == 0) ? p->in[4] + (size_t)((b * 2 + dir) * 16 + h) * 4096 : nullptr; R.init_ident = kind;
                R.yout = (kind == 0 && seg == 0) ? Y + (size_t)dir * M_ALL * D : nullptr;
                R.fin = SEGF + ((size_t)(scan * NSEG + seg) * 2 + kind) * 4096;
                scan_run(p, R, sm, lane);
            }
        }
    }
}
DI void phase_combine(KP p, LAS float* sm, const int tid) {
    const float* SEGF = (const float*)(p->ws + WS_SEGF); float* TS = (float*)(p->ws + WS_TS);
    for (int scan = blockIdx.x; scan < 64; scan += gridDim.x) {
        const int i = tid >> 3, c0 = (tid & 7) * 8;
        float cur[8];
        { const float* L0 = SEGF + ((size_t)(scan * NSEG + 0) * 2 + 0) * 4096 + i * 64 + c0;
#pragma unroll
          for (int e = 0; e < 8; ++e) cur[e] = L0[e]; }
        for (int k = 1; k < NSEG; ++k) {
            float* Tk = TS + (size_t)(scan * NSEG + k) * 4096 + i * 64 + c0;
#pragma unroll
            for (int e = 0; e < 8; ++e) { Tk[e] = cur[e]; sm[i * 64 + c0 + e] = cur[e]; }
            if (k == NSEG - 1) break;
            __syncthreads();
            const float* Pk = SEGF + ((size_t)(scan * NSEG + k) * 2 + 1) * 4096;
            const float* Lk = SEGF + ((size_t)(scan * NSEG + k) * 2 + 0) * 4096 + i * 64 + c0;
            float acc[8];
#pragma unroll
            for (int e = 0; e < 8; ++e) acc[e] = Lk[e];
            for (int j = 0; j < 64; ++j) { const float tv = sm[i * 64 + j]; const f32x4 p0 = *(const f32x4*)(Pk + j * 64 + c0), p1 = *(const f32x4*)(Pk + j * 64 + c0 + 4);
                acc[0] += tv * p0.x; acc[1] += tv * p0.y; acc[2] += tv * p0.z; acc[3] += tv * p0.w; acc[4] += tv * p1.x; acc[5] += tv * p1.y; acc[6] += tv * p1.z; acc[7] += tv * p1.w; }
#pragma unroll
            for (int e = 0; e < 8; ++e) cur[e] = acc[e];
            __syncthreads();
        }
        __syncthreads();
    }
}
DI void phase_scan2(KP p, LAS float* sm, int wave, int lane) {
    bf16_t* Y = (bf16_t*)(p->ws + WS_Y); const float* TS = (const float*)(p->ws + WS_TS);
    if (wave >= 4) return;
    for (int q2 = blockIdx.x * 4 + wave; q2 < 960; q2 += gridDim.x * 4) {
        const int scan = q2 / 15, seg = 1 + q2 % 15; int b, h, dir; lat_scan_ids(scan, b, h, dir);
        ScanRun R; R.row0 = M_CTX + b * 2048; R.h = h; R.dir = dir; R.t_first = dir ? (2047 - LSEG * seg) : LSEG * seg; R.nsteps = LSEG; R.kind = 0;
        R.init = TS + (size_t)(scan * NSEG + seg) * 4096; R.init_ident = 0; R.yout = Y + (size_t)dir * M_ALL * D; R.fin = nullptr;
        scan_run(p, R, sm, lane);
    }
}
DI void phase_rwkv_post(KP p, const WaveCtx& w) {
    const bf16_t* RKV = (const bf16_t*)(p->ws + WS_B); const bf16_t* AA = (const bf16_t*)(p->ws + WS_AA); const bf16_t* Y = (const bf16_t*)(p->ws + WS_Y);
    const bf16_t* Gt = (const bf16_t*)(p->ws + WS_RG); bf16_t* AO = (bf16_t*)(p->ws + WS_RAO);
    for (int u = w.gw; u < M_ALL * 2; u += w.ngw) {
        const int row = u >> 1, c0 = (u & 1) * 512 + w.lane * 8;
        float yf[8], yb[8], r[8], k[8], v[8], a0[8], a1[8], g[8];
        unpack8(*(const u32x4*)(Y + (size_t)row * D + c0), yf); unpack8(*(const u32x4*)(Y + (size_t)(M_ALL + row) * D + c0), yb);
        unpack8(*(const u32x4*)(RKV + (size_t)row * 3072 + c0), r); unpack8(*(const u32x4*)(RKV + (size_t)row * 3072 + 1024 + c0), k); unpack8(*(const u32x4*)(RKV + (size_t)row * 3072 + 2048 + c0), v);
        unpack8(*(const u32x4*)(AA + (size_t)row * D + c0), a0); unpack8(*(const u32x4*)(AA + (size_t)(M_ALL + row) * D + c0), a1);
        unpack8(*(const u32x4*)(Gt + (size_t)row * D + c0), g);
        float y[8], sy = 0.f, bo = 0.f;
#pragma unroll
        for (int e = 0; e < 8; ++e) { y[e] = yf[e] + yb[e]; sy += y[e];
            const float ka = p->in[30][c0 + e]; bo += r[e] * p->in[31][c0 + e] * k[e] * (2.f + (a0[e] + a1[e] - 2.f) * ka); }
        const float mu = sum8(sy) * (1.f / 64.f); bo = sum8(bo);
        float sv = 0.f;
#pragma unroll
        for (int e = 0; e < 8; ++e) { y[e] -= mu; sv += y[e] * y[e]; }
        const float rstd = rsqrtf(sum8(sv) * (1.f / 64.f) + 64e-5f);
        float o[8];
#pragma unroll
        for (int e = 0; e < 8; ++e) o[e] = (y[e] * rstd * p->in[32][c0 + e] + p->in[33][c0 + e] + bo * v[e]) * g[e];
        *(u32x4*)(AO + (size_t)row * D + c0) = pack8(o);
    }
}

#define GAS __attribute__((address_space(1)))
#define XB_TMO      128
#define XB_XCNT(j)  (256  + 64 * (j))
#define XB_XSUB(j)  (1280 + 64 * (j))
#define XB_XGEN(j)  (2304 + 64 * (j))
#define XB_TOP      3328
#define XB_TOPGEN   3392
#define XCD_BAR_WORDS 3456
#define XB_SPIN_CAP (1u << 18)

__device__ __forceinline__ unsigned xb_ld(unsigned* p)              { return __hip_atomic_load(p, __ATOMIC_RELAXED, __HIP_MEMORY_SCOPE_AGENT); }
__device__ __forceinline__ unsigned xb_add(unsigned* p, unsigned v) { return __hip_atomic_fetch_add(p, v, __ATOMIC_RELAXED, __HIP_MEMORY_SCOPE_AGENT); }
__device__ __forceinline__ unsigned xb_xcc_id() { return (unsigned)__builtin_amdgcn_s_getreg((3 << 11) | 20) & 0xFu; }
#define XB_SPIN(cond, bar) do { unsigned _sp = 0; while (cond) { __builtin_amdgcn_s_sleep(1); \
    if ((++_sp & 255u) == 0u) { if (xb_ld(&(bar)[XB_TMO])) break; if (_sp > XB_SPIN_CAP) { atomicAdd(&(bar)[XB_TMO], 1u); break; } } } } while (0)

struct XcdBarrier {
    unsigned* bar; unsigned x;
    volatile LAS unsigned* st;
};

__device__ __forceinline__ XcdBarrier xcd_barrier_post(unsigned* bar, volatile LAS unsigned* st) {
    XcdBarrier b; b.bar = bar; b.x = xb_xcc_id(); b.st = st;
    if (threadIdx.x == 0) (void)xb_add(&bar[XB_XCNT(b.x)], 1u);
    return b;
}
__device__ __forceinline__ void xcd_barrier_complete(unsigned* bar, unsigned x, unsigned& nloc, unsigned& nx) {
    const unsigned G = gridDim.x * gridDim.y * gridDim.z;
    unsigned sum, cnt, mine, sp = 0u;
    for (;;) {
        sum = 0u; cnt = 0u; mine = 0u;
#pragma unroll
        for (unsigned j = 0; j < 16; ++j) { const unsigned c = xb_ld(&bar[XB_XCNT(j)]); sum += c; cnt += (c > 0u) ? 1u : 0u; mine = (j == x) ? c : mine; }
        if (sum == G) break;
        __builtin_amdgcn_s_sleep(1);
        if ((++sp & 255u) == 0u) { if (xb_ld(&bar[XB_TMO])) break; if (sp > XB_SPIN_CAP) { atomicAdd(&bar[XB_TMO], 1u); break; } }
    }
    nloc = mine > 0u ? mine : 1u; nx = cnt > 0u ? cnt : 1u;
}

__device__ __forceinline__ void xcd_barrier(const XcdBarrier& b) {
    asm volatile("s_waitcnt vmcnt(0)" ::: "memory");
    __syncthreads();
    if (threadIdx.x == 0) {
        unsigned* bar = b.bar;
        __builtin_amdgcn_s_waitcnt(0);
        unsigned nloc = b.st[0], nx = b.st[1];
        if (nloc == 0u) { xcd_barrier_complete(bar, b.x, nloc, nx); b.st[0] = nloc; b.st[1] = nx; }
        const unsigned old = xb_add(&bar[XB_XSUB(b.x)], 1u);
        const unsigned gen = old / nloc;
        if (old + 1u == (gen + 1u) * nloc) {
            __builtin_amdgcn_fence(__ATOMIC_RELEASE, "agent");
            asm volatile("s_waitcnt vmcnt(0)" ::: "memory");
            const unsigned og = xb_add(&bar[XB_TOP], 1u);
            const unsigned tg = og / nx;
            if (og + 1u == (tg + 1u) * nx) xb_add(&bar[XB_TOPGEN], 1u);
            else XB_SPIN(xb_ld(&bar[XB_TOPGEN]) == tg, bar);
            __builtin_amdgcn_fence(__ATOMIC_ACQUIRE, "agent");
            xb_add(&bar[XB_XGEN(b.x)], 1u);
            asm volatile("s_waitcnt vmcnt(0)" ::: "memory");
        } else {
            XB_SPIN(xb_ld(&bar[XB_XGEN(b.x)]) == gen, bar);
            __builtin_amdgcn_fence(__ATOMIC_ACQUIRE, "agent");
            asm volatile("s_waitcnt vmcnt(0)" ::: "memory");
        }
    }
    __syncthreads();
}


constexpr int LDS_BYTES = 147456;
constexpr int NPHASES = 37;
constexpr int LDS_BST = 139264;

#ifndef N_LAUNCH_MODE
#define N_LAUNCH_MODE 1
#endif
enum Op { OP_P0 = 0, OP_NORM, OP_GEMM_QKV, OP_QKPREP, OP_ATTN, OP_GEMM_WO, OP_NORM_R, OP_GEMM_S1, OP_GEMM_S2A, OP_GEMM_S2B, OP_SCAN1, OP_COMBINE, OP_SCAN2, OP_POST, OP_NORM_MLP, OP_GEMM_UP, OP_GEMM_DOWN };
#ifndef PHMASK
#define PHMASK 0xFFFFFFFFu
#endif
__host__ __device__ inline void decode_phase(int pc, int& layer, int& op) {
    if (pc == 0) { layer = 0; op = OP_P0; return; }
    int r = pc - 1;
    if (r < 8) layer = 0; else if (r < 20) { layer = 1; r -= 8; } else if (r < 28) { layer = 2; r -= 20; } else { layer = 3; r -= 28; }
    if (layer != 1) { op = (r < 5) ? (OP_NORM + r) : (OP_NORM_MLP + (r - 5)); }
    else { op = (r < 8) ? (OP_NORM_R + r) : (r == 8 ? OP_GEMM_WO : OP_NORM_MLP + (r - 9)); }
}
DI void run_op(KP p, int layer, int op, LAS unsigned char* lds, const int tid) {
        const int lane = tid & 63, wave = __builtin_amdgcn_readfirstlane(tid >> 6);
        WaveCtx w; w.gw = blockIdx.x * 8 + wave; w.ngw = gridDim.x * 8; w.lane = lane; w.scr = (LAS float*)(lds + wave * 16384);
        const int kind = layer % 3, j = layer / 3;
        const float* modl = (const float*)(p->ws + WS_MOD) + (size_t)layer * 3 * MODW;
        int gk = 0;
        const bf16_t* gA = nullptr; const bf16_t* gB = nullptr; int lda = 0, ldb = 0, gN = 0, gK = 0;
        EpiAct EA{nullptr, 0, 0, nullptr, 0, nullptr, nullptr}; EpiRes ER{p->out + O_X, nullptr};
        if (!((PHMASK >> op) & 1u)) op = -1;
        switch (op) {
        case OP_P0: phase_mod(p, lds, tid); convert_mixer_weights(p, w, 0); break;
        case OP_NORM: if (layer > 0) convert_mixer_weights(p, w, layer); phase_norm(p, w, layer, 0); break;
        case OP_GEMM_QKV: { const int ldq = kind == 0 ? 3072 : 1536; gk = 1; gA = (const bf16_t*)(p->ws + WS_A); lda = D; gB = (const bf16_t*)(p->ws + WS_WQKVT); ldb = D; gN = ldq; gK = D;
            EA.O = (bf16_t*)(p->ws + WS_QKV); EA.ldc = ldq; EA.mode = 0; } break;
        case OP_QKPREP: { const AttnCfg cfg = make_cfg(p, kind, j); phase_qkprep(p, w, cfg, lds + wave * 16384); } break;
        case OP_ATTN: if (kind == 0) phase_attn_da(p, layer, wave, lane, (LAS float*)(lds + wave * 16384)); else phase_attn_swa(p, wave, lane); break;
        case OP_GEMM_WO: gk = 2; gA = (const bf16_t*)(p->ws + (kind == 1 ? WS_RAO : WS_AO)); lda = D; gB = (const bf16_t*)(p->ws + (kind == 1 ? WS_RWO : WS_WOT)); ldb = D; gN = D; gK = D; ER.gate3 = modl + 2 * D; break;
        case OP_NORM_R: convert_mixer_weights(p, w, layer); phase_norm_rwkv(p, w, layer); break;
        case OP_GEMM_S1: gk = 1; gA = (const bf16_t*)(p->ws + WS_A); lda = 2048; gB = (const bf16_t*)(p->ws + WS_S1T); ldb = 2048; gN = 3584; gK = 2048;
            EA.O = (bf16_t*)(p->ws + WS_B); EA.ldc = 3072; EA.mode = 2; EA.O2 = (bf16_t*)(p->ws + WS_LORA); EA.ldc2 = 512; break;
        case OP_GEMM_S2A: gk = 1; gA = (const bf16_t*)(p->ws + WS_LORA); lda = 512; gB = (const bf16_t*)(p->ws + WS_S2T); ldb = 256; gN = 4096; gK = 256;
            EA.O = (bf16_t*)(p->ws + WS_E); EA.ldc = D; EA.mode = 3; EA.O2 = (bf16_t*)(p->ws + WS_AA); EA.ldc2 = D; EA.b0 = p->in[21]; EA.b1 = p->in[24]; break;
        case OP_GEMM_S2B: gk = 1; gA = (const bf16_t*)(p->ws + WS_LORA) + 256; lda = 512; gB = (const bf16_t*)(p->ws + WS_G2T); ldb = 256; gN = D; gK = 256;
            EA.O = (bf16_t*)(p->ws + WS_RG); EA.ldc = D; EA.mode = 0; break;
        case OP_SCAN1: phase_scan1(p, (LAS float*)(lds + wave * 12288), wave, lane); break;
        case OP_COMBINE: phase_combine(p, (LAS float*)lds, tid); break;
        case OP_SCAN2: phase_scan2(p, (LAS float*)(lds + wave * 12288), wave, lane); break;
        case OP_POST: phase_rwkv_post(p, w); break;
        case OP_NORM_MLP: convert_mlp_weights(p, w, layer); phase_norm(p, w, layer, 1); break;
        case OP_GEMM_UP: gk = 1; gA = (const bf16_t*)(p->ws + WS_A); lda = D; gB = (const bf16_t*)(p->ws + WS_W1T); ldb = D; gN = FFD; gK = D;
            EA.O = (bf16_t*)(p->ws + WS_B); EA.ldc = FFD; EA.mode = 1; break;
        case OP_GEMM_DOWN: gk = 2; gA = (const bf16_t*)(p->ws + WS_B); lda = FFD; gB = (const bf16_t*)(p->ws + WS_W2T); ldb = FFD; gN = D; gK = FFD; ER.gate3 = modl + 5 * D; break;
        default: break;
        }
        if (gk == 1) run_gemm(lds, gA, lda, gB, ldb, gN, gK, EA, tid);
        else if (gk == 2) run_gemm(lds, gA, lda, gB, ldb, gN, gK, ER, tid);
}

#if N_LAUNCH_MODE == 1
__global__ void __launch_bounds__(512, 2) trunk_fwd(Params p_) {
    extern __shared__ __attribute__((aligned(16))) unsigned char lds_raw[];
    LAS unsigned char* lds = (LAS unsigned char*)lds_raw;
    cg::grid_group grid = cg::this_grid();
    const int ph_lo = p_.ph_lo, ph_hi = p_.ph_hi;
    volatile LAS unsigned* bst = (volatile LAS unsigned*)(lds + LDS_BST);
    if (threadIdx.x < 2) bst[threadIdx.x] = 0u;
    __syncthreads();
    XcdBarrier xbar = xcd_barrier_post((unsigned*)(p_.ws + WS_BAR), bst);
    for (int pc = ph_lo; pc < ph_hi; ++pc) {
        KP p = (KP)__builtin_amdgcn_kernarg_segment_ptr(); asm volatile("" : "+s"(p));
        int layer, op; decode_phase(pc, layer, op);
        int tid = threadIdx.x; asm volatile("" : "+v"(tid));
        run_op(p, layer, op, lds, tid);
        if (pc + 1 < ph_hi) { if (pc == ph_lo) grid.sync(); else xcd_barrier(xbar); }
    }
}
#else
template <int OP> __global__ void __launch_bounds__(512, 2) k_op(Params p_) {
    extern __shared__ __attribute__((aligned(16))) unsigned char lds_raw[];
    KP p = (KP)__builtin_amdgcn_kernarg_segment_ptr();
    run_op(p, p_.ph_lo, OP, (LAS unsigned char*)lds_raw, threadIdx.x);
}

#endif
extern "C" void kernel_launch(void* const* d_in, const int* in_sizes, int n_in, void* d_out, int out_size, void* d_ws, size_t ws_size, hipStream_t stream) {
    static int grid = 0;
    if (grid == 0) {
        if (n_in != 40 || ws_size < WS_END || out_size != 54525952) { fprintf(stderr, "kernel_launch: unexpected problem (n_in %d, ws %zu, out %d)\n", n_in, ws_size, out_size); grid = -1; return; }
        int dev = 0, cus = 0, per_cu = 0;
        if (hipGetDevice(&dev) != hipSuccess || hipDeviceGetAttribute(&cus, hipDeviceAttributeMultiprocessorCount, dev) != hipSuccess) { grid = -1; return; }
#if N_LAUNCH_MODE == 1
        if (hipFuncSetAttribute((const void*)trunk_fwd, hipFuncAttributeMaxDynamicSharedMemorySize, LDS_BYTES) != hipSuccess) { fprintf(stderr, "kernel_launch: hipFuncSetAttribute failed\n"); grid = -1; return; }
        if (hipOccupancyMaxActiveBlocksPerMultiprocessor(&per_cu, (const void*)trunk_fwd, 512, LDS_BYTES) != hipSuccess || per_cu < 1) { fprintf(stderr, "kernel_launch: occupancy query says %d\n", per_cu); grid = -1; return; }
#else
        per_cu = 1;
#endif
        grid = cus * per_cu;
        if (grid > 256) grid = 256;
    }
    if (grid < 0) return;
    if (hipMemsetAsync((char*)d_ws + WS_BAR, 0, 16384, stream) != hipSuccess) { fprintf(stderr, "kernel_launch: memset failed\n"); return; }
    Params p{};
    for (int i = 0; i < 40; ++i) p.in[i] = (const float*)d_in[i];
    p.out = (float*)d_out; p.ws = (unsigned char*)d_ws;
#if N_LAUNCH_MODE == 1
    p.ph_lo = 0; p.ph_hi = NPHASES;
    void* args[] = {&p};
    hipError_t e = hipLaunchCooperativeKernel((const void*)trunk_fwd, dim3(grid), dim3(512), args, LDS_BYTES, stream);
    if (e != hipSuccess) fprintf(stderr, "cooperative launch failed: %s (grid %d)\n", hipGetErrorString(e), grid);
#else
    for (int ph = 0; ph < NPHASES; ++ph) {
        int layer, op; decode_phase(ph, layer, op);
        p.ph_lo = layer; p.ph_hi = 0;
#define LOP(X) case X: { static bool once##X = false; if (!once##X) { (void)hipFuncSetAttribute((const void*)k_op<X>, hipFuncAttributeMaxDynamicSharedMemorySize, LDS_BYTES); once##X = true; } hipLaunchKernelGGL(k_op<X>, dim3(grid), dim3(512), LDS_BYTES, stream, p); } break;
        switch (op) { LOP(0) LOP(1) LOP(2) LOP(3) LOP(4) LOP(5) LOP(6) LOP(7) LOP(8) LOP(9) LOP(10) LOP(11) LOP(12) LOP(13) LOP(14) LOP(15) LOP(16) default: break; }
#undef LOP
    }
#endif
}
```

```cpp
#include <hip/hip_runtime.h>
#include <hip/hip_cooperative_groups.h>
#include <cstdio>
#include <cstdint>
namespace cg = cooperative_groups;
#define DI __device__ __forceinline__
namespace pg8 {
#define PG8_LAS __attribute__((address_space(3)))
typedef unsigned short bf16_t;
typedef short bf16x8 __attribute__((ext_vector_type(8)));
typedef float f32x4 __attribute__((ext_vector_type(4)));
typedef unsigned u32x4 __attribute__((ext_vector_type(4)));
constexpr int BM = 256, BK = 64, HALF = 128, HTB = HALF * BK * 2  , STAGE_BYTES = 8 * HTB, NXCD = 8, WGM = 8;

__host__ __device__ __forceinline__ int lds_byte(int r, int c) { const int st = (r >> 4) * 2 + (c >> 5), rr = r & 15, cc = c & 31, ob = rr * 64 + cc * 2; return st * 1024 + (ob ^ (((ob >> 9) & 1) << 5)); }
__host__ __device__ __forceinline__ void stage_rc(int b, int& R, int& C) { const int st = b / 1024, sb = b % 1024, swz = sb ^ (((sb >> 9) & 1) << 5); R = (st >> 1) * 16 + swz / 64; C = (st & 1) * 32 + (swz % 64) / 2; }
__host__ __device__ __forceinline__ int perm32(int rho) { const int n = rho >> 4, i = rho & 15; return 8 * (i >> 2) + 4 * n + (i & 3); }

struct Unit { int pm, pn; };
struct Gemm { const bf16_t* A; const bf16_t* Bt; int lda, ldb, M, N, K; };

struct StaticOrder {
    int nM, nN, nwg, G, c;
    __host__ __device__ void init(int M, int N, int G_, int c_) { nM = M / BM; nN = N / BM; nwg = nM * nN; G = G_; c = c_; }
    __host__ __device__ bool next(int i, Unit& u) const {
        const long L = (long)i * G + c; if (L >= nwg) return false;
        int wgid = (int)L; { const int q = nwg / NXCD, r = nwg % NXCD, xcd = wgid % NXCD, off = wgid / NXCD; wgid = (xcd < r ? xcd * (q + 1) : r * (q + 1) + (xcd - r) * q) + off; }
        const int nig = WGM * nN, gid = wgid / nig, fm = gid * WGM, gsz = (nM - fm) < WGM ? (nM - fm) : WGM;
        u.pm = fm + ((wgid % nig) % gsz); u.pn = (wgid % nig) / gsz; return true;
    }
    __device__ __forceinline__ void a_ready(const Unit&) const {}
    __device__ __forceinline__ void done(const Unit&) const {}
};


template <class Epi, class Sched, bool ALIGN_EPI = false, bool SP2 = false>
__device__ __forceinline__ void gemm_phase(PG8_LAS unsigned char* lds, const Gemm g, const Sched& S, const Epi& E, const int tid) {
    const int wid = __builtin_amdgcn_readfirstlane(tid >> 6), lane = tid & 63, wr = wid >> 2, wc = wid & 3, fr = lane & 15, fq = lane >> 4;
    const int K = g.K, nt = K / BK;
    unsigned voffA[2], voffB[2];
#pragma unroll
    for (int i = 0; i < 2; ++i) { int R, C; stage_rc(tid * 16 + i * 8192, R, C); const int Rb = Epi::PERM ? ((R & ~31) + perm32(R & 31)) : R;
        voffA[i] = (unsigned)(R * g.lda + C) * 2u; voffB[i] = (unsigned)(Rb * g.ldb + C) * 2u; }
    const size_t kstep = (size_t)(BK * 2);
    const size_t hstepA = (size_t)HALF * g.lda * 2, hstepB = (size_t)HALF * g.ldb * 2;
    const size_t tstepA = 2 * hstepA, tstepB = 2 * hstepB;
    const unsigned ldsw = (unsigned)wid * 1024u;
    const int aoff = lds_byte(wr * 64 + fr, fq * 8), boff = lds_byte(wc * 32 + fr, fq * 8);
#define PG8_SA(b, h) (((b) * 2 + (h)) * HTB)
#define PG8_SB(b, h) ((4 + (b) * 2 + (h)) * HTB)
#define PG8_STAGE(bufoff, gbase, voff) do { _Pragma("unroll") for (int _i = 0; _i < 2; ++_i) \
        __builtin_amdgcn_global_load_lds((const unsigned*)((const char*)(gbase) + (voff)[_i]), (PG8_LAS unsigned*)(lds + (bufoff) + ldsw + _i * 8192), 16, 0, 0); } while (0)
#define PG8_LDA(dst, b, h) do { _Pragma("unroll") for (int m = 0; m < 4; ++m) _Pragma("unroll") for (int k = 0; k < 2; ++k) dst[m][k] = *(const PG8_LAS bf16x8*)(lds + PG8_SA(b, h) + aoff + m * 2048 + k * 1024); } while (0)
#define PG8_LDB(dst, b, h) do { _Pragma("unroll") for (int n = 0; n < 2; ++n) _Pragma("unroll") for (int k = 0; k < 2; ++k) dst[n][k] = *(const PG8_LAS bf16x8*)(lds + PG8_SB(b, h) + boff + n * 2048 + k * 1024); } while (0)
#define PG8_MMA(ai, bj, At, Bt) do { __builtin_amdgcn_s_setprio(1); _Pragma("unroll") for (int m = 0; m < 4; ++m) _Pragma("unroll") for (int n = 0; n < 2; ++n) _Pragma("unroll") for (int k = 0; k < 2; ++k) \
        acc[ai][bj][m][n] = __builtin_amdgcn_mfma_f32_16x16x32_bf16(Bt[n][k], At[m][k], acc[ai][bj][m][n], 0, 0, 0); __builtin_amdgcn_s_setprio(0); } while (0)
#define PG8_WAIT_V(n) asm volatile("s_waitcnt vmcnt(" #n ")" ::: "memory")
#define PG8_WAIT_L(n) asm volatile("s_waitcnt lgkmcnt(" #n ")" ::: "memory")
#define PG8_BAR __builtin_amdgcn_s_barrier()
#define PG8_SCHED __builtin_amdgcn_sched_barrier(0)
    Unit cur, nxt; int ui = 0;
    if (!S.next(0, cur)) return;
    f32x4 acc[2][2][4][2];
#pragma unroll
    for (int a = 0; a < 2; ++a)
#pragma unroll
        for (int b = 0; b < 2; ++b)
#pragma unroll
            for (int m = 0; m < 4; ++m)
#pragma unroll
                for (int n = 0; n < 2; ++n) acc[a][b][m][n] = (f32x4){0.f, 0.f, 0.f, 0.f};
    bf16x8 At[4][2], B0[2][2], B1[2][2];
    const char* cA = (const char*)g.A + (size_t)cur.pm * tstepA; const char* cB = (const char*)g.Bt + (size_t)cur.pn * tstepB;
    S.a_ready(cur);
    if constexpr (SP2) {
        PG8_STAGE(PG8_SB(0, 0), cB, voffB); PG8_STAGE(PG8_SB(0, 1), cB + hstepB, voffB); PG8_STAGE(PG8_SA(0, 0), cA, voffA); PG8_STAGE(PG8_SA(0, 1), cA + hstepA, voffA);
        if (wr == 1) PG8_BAR;
        PG8_WAIT_V(2); PG8_BAR;
        PG8_STAGE(PG8_SB(1, 0), cB + kstep, voffB); PG8_STAGE(PG8_SA(1, 0), cA + kstep, voffA); PG8_STAGE(PG8_SB(1, 1), cB + hstepB + kstep, voffB);
        PG8_WAIT_V(6); PG8_BAR;
    } else {
        PG8_STAGE(PG8_SB(0, 0), cB, voffB); PG8_STAGE(PG8_SA(0, 0), cA, voffA); PG8_STAGE(PG8_SB(0, 1), cB + hstepB, voffB); PG8_STAGE(PG8_SA(0, 1), cA + hstepA, voffA);
        if (wr == 1) PG8_BAR;
        PG8_WAIT_V(4); PG8_BAR;
        PG8_STAGE(PG8_SB(1, 0), cB + kstep, voffB); PG8_STAGE(PG8_SA(1, 0), cA + kstep, voffA); PG8_STAGE(PG8_SB(1, 1), cB + hstepB + kstep, voffB);
        PG8_WAIT_V(6); PG8_BAR;
    }
    for (;;) {
        const bool has_next = S.next(ui + 1, nxt);
        const char* nA = has_next ? (const char*)g.A + (size_t)nxt.pm * tstepA : cA; const char* nB = has_next ? (const char*)g.Bt + (size_t)nxt.pn * tstepB : cB;
        for (int t = 0; t < nt; t += 2) {
            const bool last = (t == nt - 2);
            const char* a1 = cA + (size_t)(t + 1) * kstep;
            const char* a2 = last ? nA : cA + (size_t)(t + 2) * kstep; const char* b2 = last ? nB : cB + (size_t)(t + 2) * kstep;
            const char* a3 = a2 + kstep; const char* b3 = b2 + kstep;
            if (last && has_next) S.a_ready(nxt);
            if constexpr (SP2) {
            PG8_LDB(B0, 0, 0); PG8_LDB(B1, 0, 1); PG8_SCHED; PG8_LDA(At, 0, 0); PG8_STAGE(PG8_SA(1, 1), a1 + hstepA, voffA);
            PG8_WAIT_V(8); PG8_WAIT_L(0); PG8_BAR; PG8_MMA(0, 0, At, B0); PG8_MMA(0, 1, At, B1); PG8_BAR; PG8_SCHED;
            PG8_LDA(At, 0, 1); PG8_STAGE(PG8_SB(0, 0), b2, voffB); PG8_STAGE(PG8_SB(0, 1), b2 + hstepB, voffB); PG8_STAGE(PG8_SA(0, 0), a2, voffA);
            PG8_WAIT_V(8); PG8_WAIT_L(0); PG8_BAR; PG8_MMA(1, 0, At, B0); PG8_MMA(1, 1, At, B1); PG8_BAR; PG8_SCHED;
            PG8_LDB(B0, 1, 0); PG8_LDB(B1, 1, 1); PG8_SCHED; PG8_LDA(At, 1, 0); PG8_STAGE(PG8_SA(0, 1), a2 + hstepA, voffA);
            PG8_WAIT_V(8); PG8_WAIT_L(0); PG8_BAR; PG8_MMA(0, 0, At, B0); PG8_MMA(0, 1, At, B1); PG8_BAR; PG8_SCHED;
            PG8_LDA(At, 1, 1); PG8_STAGE(PG8_SB(1, 0), b3, voffB); PG8_STAGE(PG8_SB(1, 1), b3 + hstepB, voffB); PG8_STAGE(PG8_SA(1, 0), a3, voffA);
            PG8_WAIT_V(8); PG8_WAIT_L(0); PG8_BAR; PG8_MMA(1, 0, At, B0); PG8_MMA(1, 1, At, B1); PG8_BAR; PG8_SCHED;
            } else {
            PG8_LDB(B0, 0, 0); PG8_SCHED; PG8_LDA(At, 0, 0); PG8_STAGE(PG8_SA(1, 1), a1 + hstepA, voffA);
            PG8_WAIT_L(8); PG8_BAR; PG8_WAIT_L(0); PG8_MMA(0, 0, At, B0); PG8_BAR; PG8_SCHED;
            PG8_LDB(B1, 0, 1); PG8_STAGE(PG8_SB(0, 0), b2, voffB);
            PG8_BAR; PG8_WAIT_L(0); PG8_MMA(0, 1, At, B1); PG8_BAR;
            PG8_LDA(At, 0, 1); PG8_STAGE(PG8_SA(0, 0), a2, voffA);
            PG8_BAR; PG8_WAIT_L(0); PG8_MMA(1, 0, At, B0); PG8_BAR; PG8_SCHED;
            PG8_STAGE(PG8_SB(0, 1), b2 + hstepB, voffB);
            PG8_WAIT_V(6); PG8_BAR; PG8_MMA(1, 1, At, B1); PG8_BAR;
            PG8_LDB(B0, 1, 0); PG8_SCHED; PG8_LDA(At, 1, 0); PG8_STAGE(PG8_SA(0, 1), a2 + hstepA, voffA);
            PG8_WAIT_L(8); PG8_BAR; PG8_WAIT_L(0); PG8_MMA(0, 0, At, B0); PG8_BAR; PG8_SCHED;
            PG8_LDB(B1, 1, 1); PG8_STAGE(PG8_SB(1, 0), b3, voffB);
            PG8_BAR; PG8_WAIT_L(0); PG8_MMA(0, 1, At, B1); PG8_BAR;
            PG8_LDA(At, 1, 1); PG8_STAGE(PG8_SA(1, 0), a3, voffA);
            PG8_BAR; PG8_WAIT_L(0); PG8_MMA(1, 0, At, B0); PG8_BAR; PG8_SCHED;
            PG8_STAGE(PG8_SB(1, 1), b3 + hstepB, voffB);
            PG8_WAIT_V(6); PG8_BAR; PG8_MMA(1, 1, At, B1); PG8_BAR;
            }
        }
        if constexpr (ALIGN_EPI) { if (wr == 0) PG8_BAR; }
        if constexpr (!Epi::AFTER_DRAIN) { E(acc, cur, wr, wc, fr, fq); S.done(cur); }
        if (!has_next) break;
#pragma unroll
        for (int a = 0; a < 2; ++a)
#pragma unroll
            for (int b = 0; b < 2; ++b)
#pragma unroll
                for (int m = 0; m < 4; ++m)
#pragma unroll
                    for (int n = 0; n < 2; ++n) acc[a][b][m][n] = (f32x4){0.f, 0.f, 0.f, 0.f};
        cur = nxt; cA = nA; cB = nB; ++ui;
        if constexpr (ALIGN_EPI) { if (wr == 1) PG8_BAR; }
    }
    PG8_WAIT_V(0);
    if constexpr (!ALIGN_EPI) { if (wr == 0) PG8_BAR; }
    PG8_BAR;
    if constexpr (Epi::AFTER_DRAIN) { E.fused(acc, cur, wr, wc, fr, fq, lds, wid, lane); S.done(cur); }
#undef PG8_SA
#undef PG8_SB
#undef PG8_STAGE
#undef PG8_LDA
#undef PG8_LDB
#undef PG8_MMA
#undef PG8_WAIT_V
#undef PG8_WAIT_L
#undef PG8_BAR
#undef PG8_SCHED
}
}


#define LAS __attribute__((address_space(3)))
typedef unsigned short bf16_t;
typedef short bf16x8 __attribute__((ext_vector_type(8)));
typedef float f32x4 __attribute__((ext_vector_type(4)));
typedef float f32x2 __attribute__((ext_vector_type(2)));
typedef float f32x16 __attribute__((ext_vector_type(16)));
typedef unsigned u32x4 __attribute__((ext_vector_type(4)));
typedef unsigned u32x2 __attribute__((ext_vector_type(2)));
typedef __bf16 bf16x2_t __attribute__((ext_vector_type(2)));

constexpr int D = 1024, FFD = 4096, M_CTX = 8192, M_LAT = 4096, M_ALL = 12288, T_CTX = 256, T_LAT = 2048, NPAST = 256;
constexpr int MODW = 6144;
constexpr size_t MiB = 1u << 20;
constexpr size_t O_X = 0, O_DAK = 12582912, O_DAV = 29360128, O_RW = 46137344, O_SWK = 50331648, O_SWV = 52428800;
constexpr size_t WS_MOD = 0;
constexpr size_t WS_BAR = 400 * 1024;
constexpr size_t WS_ROPE = 512 * 1024;
constexpr size_t WS_SEGF = 1 * MiB;
constexpr size_t WS_W = 33 * MiB;
constexpr size_t WS_A = 53 * MiB;
constexpr size_t WS_B = 101 * MiB;
constexpr size_t WS_C = 197 * MiB;
constexpr size_t WS_END = 341 * MiB;
constexpr size_t WS_W1T = WS_A + 24 * MiB, WS_W2T = WS_A + 32 * MiB;
constexpr size_t WS_QKV = WS_B, WS_AO = WS_B + 72 * MiB;
constexpr size_t WS_LORA = WS_B + 72 * MiB;
constexpr size_t WS_RG = WS_A, WS_RAO = WS_A + 24 * MiB, WS_TS = WS_A + 24 * MiB;
constexpr size_t WS_E = WS_C, WS_AA = WS_C + 48 * MiB, WS_Y = WS_C + 96 * MiB;
constexpr size_t WS_VTC = WS_C, WS_VTL = WS_C + 32 * MiB, WS_KC = WS_C + 48 * MiB, WS_KF = WS_C + 64 * MiB;
constexpr size_t WS_S1T = WS_W;
constexpr size_t WS_S2T = WS_W + 14 * MiB;
constexpr size_t WS_G2T = WS_W + 16 * MiB;
constexpr size_t WS_RWO = WS_W + 17 * MiB;
constexpr size_t WS_WQKVT = WS_W, WS_WOT = WS_W + 8 * MiB;

constexpr float LOG2E = 1.4426950408889634f;
constexpr float QSCALE = 0.125f * LOG2E;

struct Params { const float* in[40]; float* out; unsigned char* ws; int ph_lo, ph_hi, repmask, pad; };
typedef const __attribute__((address_space(4))) Params* KP;

DI unsigned cvtpk(float lo, float hi) { f32x2 v = {lo, hi}; bf16x2_t b = __builtin_convertvector(v, bf16x2_t); return __builtin_bit_cast(unsigned, b); }
DI float bflo(unsigned w) { return __uint_as_float(w << 16); }
DI float bfhi(unsigned w) { return __uint_as_float(w & 0xffff0000u); }
DI float bf2f(bf16_t b) { return __uint_as_float(((unsigned)b) << 16); }
DI void unpack8(const u32x4 w, float (&f)[8]) { f[0] = bflo(w.x); f[1] = bfhi(w.x); f[2] = bflo(w.y); f[3] = bfhi(w.y); f[4] = bflo(w.z); f[5] = bfhi(w.z); f[6] = bflo(w.w); f[7] = bfhi(w.w); }
DI u32x4 pack8(const float (&f)[8]) { u32x4 w; w.x = cvtpk(f[0], f[1]); w.y = cvtpk(f[2], f[3]); w.z = cvtpk(f[4], f[5]); w.w = cvtpk(f[6], f[7]); return w; }
template <int CTRL> DI float dpp_mov(float v) { return __uint_as_float((unsigned)__builtin_amdgcn_update_dpp(0, (int)__float_as_uint(v), CTRL, 0xF, 0xF, true)); }
DI float sum2(float v) { v += dpp_mov<0xB1>(v); return v; }
DI float sum8(float v) { v += dpp_mov<0xB1>(v); v += dpp_mov<0x4E>(v); v += dpp_mov<0x141>(v); return v; }
DI float wave_sum(float v) {
#pragma unroll
    for (int o = 1; o < 64; o <<= 1) v += __shfl_xor(v, o);
    return v;
}
DI float sigmoidf_(float x) { return 1.f / (1.f + __expf(-x)); }
DI int cond_of_row(int row) { return row < M_CTX ? 0 : (row < M_CTX + T_LAT ? 1 : 2); }

struct EpiAct {
    static constexpr bool PERM = true, AFTER_DRAIN = false;
    bf16_t* O; int ldc; int mode; bf16_t* O2; int ldc2; const float* b0; const float* b1;
    DI void operator()(const pg8::f32x4 (&acc)[2][2][4][2], const pg8::Unit& u, int wr, int wc, int fr, int fq) const {
        const int row0 = u.pm * 256 + wr * 64 + fr;
        bf16_t* base = O; int ld = ldc; int colt = u.pn * 256; int act0 = 0, act1 = 0; const float* bias = nullptr; float cmul = 1.f;
        if (mode == 1) { act0 = act1 = 1; }
        else if (mode == 2) { if (u.pn >= 12) { base = O2; ld = ldc2; colt = (u.pn - 12) * 256; act0 = (u.pn == 12) ? 2 : 3; act1 = 0; } }
        else if (mode == 3) { act0 = act1 = 4; if (u.pn < 8) { bias = b0 + u.pn * 256; cmul = 0.6065306597126334f; base = O + (size_t)(u.pn >> 2) * M_ALL * D; colt = (u.pn & 3) * 256; }
                              else { bias = b1 + (u.pn - 8) * 256; base = O2 + (size_t)((u.pn - 8) >> 2) * M_ALL * D; colt = (u.pn & 3) * 256; ld = ldc2; } }
        const int cw = wc * 32 + 8 * fq;
#pragma unroll
        for (int ai = 0; ai < 2; ++ai)
#pragma unroll
            for (int m = 0; m < 4; ++m) {
                bf16_t* rowp = base + (size_t)(row0 + ai * 128 + m * 16) * ld + colt + cw;
#pragma unroll
                for (int bj = 0; bj < 2; ++bj) {
                    const int act = bj ? act1 : act0;
                    float v[8];
#pragma unroll
                    for (int j = 0; j < 4; ++j) { v[j] = acc[ai][bj][m][0][j]; v[4 + j] = acc[ai][bj][m][1][j]; }
                    if (act == 1) {
#pragma unroll
                        for (int j = 0; j < 8; ++j) { const float r = fmaxf(v[j], 0.f); v[j] = r * r; }
                    } else if (act == 2) {
#pragma unroll
                        for (int j = 0; j < 8; ++j) { const float e2 = __expf(2.f * v[j]); v[j] = 1.f - 2.f / (e2 + 1.f); }
                    } else if (act == 3) {
#pragma unroll
                        for (int j = 0; j < 8; ++j) v[j] = sigmoidf_(v[j]);
                    } else if (act == 4) {
                        const float* bp = bias + bj * 128 + cw;
#pragma unroll
                        for (int j = 0; j < 8; ++j) v[j] = cmul * sigmoidf_(v[j] + bp[j]);
                    }
                    *(u32x4*)(rowp + bj * 128) = pack8(v);
                }
            }
    }
};
struct EpiRes {
    static constexpr bool PERM = false, AFTER_DRAIN = false;
    float* X; const float* gate3;
    DI void operator()(const pg8::f32x4 (&acc)[2][2][4][2], const pg8::Unit& u, int wr, int wc, int fr, int fq) const {
        const int cond = u.pm < 32 ? 0 : (u.pm < 40 ? 1 : 2);
        const float* g = gate3 + cond * MODW;
        const int col0 = u.pn * 256 + wc * 32 + 4 * fq, row0 = u.pm * 256 + wr * 64 + fr;
#pragma unroll
        for (int bj = 0; bj < 2; ++bj)
#pragma unroll
            for (int n = 0; n < 2; ++n) {
                const int col = col0 + bj * 128 + n * 16;
                const f32x4 gv = *(const f32x4*)(g + col);
#pragma unroll
                for (int ai = 0; ai < 2; ++ai)
#pragma unroll
                    for (int m = 0; m < 4; ++m) {
                        float* p = X + (size_t)(row0 + ai * 128 + m * 16) * D + col;
                        f32x4 v = *(const f32x4*)p; v += gv * acc[ai][bj][m][n]; *(f32x4*)p = v;
                    }
            }
    }
};

template <class Epi> DI void run_gemm(LAS unsigned char* lds, const bf16_t* A, int lda, const bf16_t* Bt, int ldb, int N, int K, const Epi& E, int tid) {
    pg8::Gemm g{A, Bt, lda, ldb, M_ALL, N, K}; pg8::StaticOrder S; S.init(M_ALL, N, (int)gridDim.x, (int)blockIdx.x);
    pg8::gemm_phase<Epi, pg8::StaticOrder, true, true>(lds, g, S, E, tid);
}

DI void titem(const float* W, int N, bf16_t* dst, int ldt, int nrow0, int kcol0, const float* ks, int kb, int nb, LAS float* scr, int lane) {
    const int k0 = 64 * kb, n0 = 32 * nb;
    const int c = lane & 7;
    if (W) {
#pragma unroll 8
        for (int i = 0; i < 32; ++i) { const int kk = 2 * i + (lane >> 5); float w = W[(size_t)(k0 + kk) * N + n0 + (lane & 31)]; if (ks) w *= ks[k0 + kk]; scr[kk * 33 + (lane & 31)] = w; }
        asm volatile("s_waitcnt lgkmcnt(0)" ::: "memory");
#pragma unroll
        for (int j = 0; j < 4; ++j) { const int n = (lane >> 3) + 8 * j; const LAS float* s = scr + (8 * c) * 33 + n;
            u32x4 o; o.x = cvtpk(s[0 * 33], s[1 * 33]); o.y = cvtpk(s[2 * 33], s[3 * 33]); o.z = cvtpk(s[4 * 33], s[5 * 33]); o.w = cvtpk(s[6 * 33], s[7 * 33]);
            *(u32x4*)(dst + (size_t)(nrow0 + n0 + n) * ldt + kcol0 + k0 + 8 * c) = o; }
        asm volatile("s_waitcnt lgkmcnt(0)" ::: "memory");
    } else {
#pragma unroll
        for (int j = 0; j < 4; ++j) { const int n = (lane >> 3) + 8 * j; *(u32x4*)(dst + (size_t)(nrow0 + n0 + n) * ldt + kcol0 + k0 + 8 * c) = (u32x4){0u, 0u, 0u, 0u}; }
    }
}
struct WaveCtx { int gw, ngw, lane; LAS float* scr; };
DI void tmat(const WaveCtx& w, int& itbase, const float* W, int K, int N, bf16_t* dst, int ldt, int nrow0, int kcol0, const float* ks) {
    const int nblk = N / 32, nit = (K / 64) * nblk;
    int first = (w.gw - itbase % w.ngw + w.ngw) % w.ngw;
    for (int it = first; it < nit; it += w.ngw) titem(W, N, dst, ldt, nrow0, kcol0, ks, it / nblk, it % nblk, w.scr, w.lane);
    itbase += nit;
}
DI void tzero(const WaveCtx& w, int& itbase, int K, int N, bf16_t* dst, int ldt, int nrow0, int kcol0) {
    const int nblk = N / 32, nit = (K / 64) * nblk;
    int first = (w.gw - itbase % w.ngw + w.ngw) % w.ngw;
    for (int it = first; it < nit; it += w.ngw) titem(nullptr, N, dst, ldt, nrow0, kcol0, nullptr, it / nblk, it % nblk, w.scr, w.lane);
    itbase += nit;
}

DI void convert_mixer_weights(KP p, const WaveCtx& w, int layer) {
    const int kind = layer % 3, j = layer / 3; unsigned char* ws = p->ws; int ib = 0;
    if (kind == 0) {
        tmat(w, ib, p->in[13] + (size_t)j * D * 3072, D, 3072, (bf16_t*)(ws + WS_WQKVT), D, 0, 0, nullptr);
        tmat(w, ib, p->in[18] + (size_t)j * D * D, D, D, (bf16_t*)(ws + WS_WOT), D, 0, 0, nullptr);
    } else if (kind == 2) {
        tmat(w, ib, p->in[35], D, 1536, (bf16_t*)(ws + WS_WQKVT), D, 0, 0, nullptr);
        tmat(w, ib, p->in[39], D, D, (bf16_t*)(ws + WS_WOT), D, 0, 0, nullptr);
    } else {
        bf16_t* s1 = (bf16_t*)(ws + WS_S1T); const float* mu = p->in[19];
        for (int m = 0; m < 3; ++m) {
            tmat(w, ib, p->in[20] + (size_t)m * D * D, D, D, s1, 2048, m * 1024, 0, nullptr);
            tmat(w, ib, p->in[20] + (size_t)m * D * D, D, D, s1, 2048, m * 1024, 1024, mu + m * D);
        }
        for (int d = 0; d < 2; ++d) {
            tmat(w, ib, p->in[22] + (size_t)d * D * 64, D, 64, s1, 2048, 3072 + d * 64, 0, nullptr);
            tmat(w, ib, p->in[22] + (size_t)d * D * 64, D, 64, s1, 2048, 3072 + d * 64, 1024, mu + 3 * D);
            tmat(w, ib, p->in[25] + (size_t)d * D * 64, D, 64, s1, 2048, 3200 + d * 64, 0, nullptr);
            tmat(w, ib, p->in[25] + (size_t)d * D * 64, D, 64, s1, 2048, 3200 + d * 64, 1024, mu + 4 * D);
        }
        tmat(w, ib, p->in[27], D, 128, s1, 2048, 3328, 0, nullptr);
        tmat(w, ib, p->in[27], D, 128, s1, 2048, 3328, 1024, mu + 5 * D);
        tzero(w, ib, 2048, 128, s1, 2048, 3456, 0);
        bf16_t* s2 = (bf16_t*)(ws + WS_S2T);
        for (int rg = 0; rg < 4; ++rg)
            for (int kb = 0; kb < 4; ++kb) {
                if (kb == rg) tmat(w, ib, (rg < 2 ? p->in[23] : p->in[26]) + (size_t)(rg & 1) * 64 * D, 64, D, s2, 256, rg * 1024, kb * 64, nullptr);
                else tzero(w, ib, 64, D, s2, 256, rg * 1024, kb * 64);
            }
        bf16_t* g2 = (bf16_t*)(ws + WS_G2T);
        tmat(w, ib, p->in[28], 128, D, g2, 256, 0, 0, nullptr);
        tzero(w, ib, 128, D, g2, 256, 0, 128);
        tmat(w, ib, p->in[34], D, D, (bf16_t*)(ws + WS_RWO), D, 0, 0, nullptr);
    }
}
DI void convert_mlp_weights(KP p, const WaveCtx& w, int layer) {
    int ib = 0;
    tmat(w, ib, p->in[11] + (size_t)layer * D * FFD, D, FFD, (bf16_t*)(p->ws + WS_W1T), D, 0, 0, nullptr);
    tmat(w, ib, p->in[12] + (size_t)layer * D * FFD, FFD, D, (bf16_t*)(p->ws + WS_W2T), FFD, 0, 0, nullptr);
}

DI void phase_mod(KP p, LAS unsigned char* lds, const int tid) {
    LAS float* sl = (LAS float*)lds;
    LAS float* red = sl + 3 * 1024;
    for (int i = tid; i < 3 * 1024; i += 512) { const int c = i >> 10, k = i & 1023; const float v = (c == 0) ? p->in[8][k] : p->in[7][(c - 1) * 1024 + k]; sl[i] = v / (1.f + __expf(-v)); }
    __syncthreads();
    float* mod = (float*)(p->ws + WS_MOD);
    const int cg_ = tid & 63, kg = tid >> 6;
    for (int unit = blockIdx.x; unit < 4 * 96; unit += gridDim.x) {
        const int l = unit / 96, c0 = (unit % 96) * 64;
        const float* W = p->in[9] + (size_t)l * D * MODW + c0 + cg_;
        float a0 = 0.f, a1 = 0.f, a2 = 0.f;
#pragma unroll 8
        for (int k = kg * 128; k < kg * 128 + 128; ++k) { const float wv = W[(size_t)k * MODW]; a0 += sl[k] * wv; a1 += sl[1024 + k] * wv; a2 += sl[2048 + k] * wv; }
        red[(kg * 3 + 0) * 64 + cg_] = a0; red[(kg * 3 + 1) * 64 + cg_] = a1; red[(kg * 3 + 2) * 64 + cg_] = a2;
        __syncthreads();
        if (tid < 192) { const int c = tid >> 6; float s = p->in[10][l * MODW + c0 + cg_];
#pragma unroll
            for (int q = 0; q < 8; ++q) s += red[(q * 3 + c) * 64 + cg_];
            mod[(size_t)(l * 3 + c) * MODW + c0 + cg_] = s; }
        __syncthreads();
    }
    float* rc = (float*)(p->ws + WS_ROPE); float* rs = rc + 2048 * 32;
    for (int i = blockIdx.x * 512 + tid; i < 2048 * 32; i += gridDim.x * 512) {
        const int t = i >> 5, jj = i & 31; const int pos = (jj < 16) ? (t >> 6) : (t & 63); const int f = jj & 15;
        const float inv = __builtin_amdgcn_exp2f(-(float)f * (13.287712379549449f / 16.f)); const float ang = (float)pos * inv;
        const float kq = rintf(ang * 0.15915494309189535f); float rr = fmaf(-kq, 6.2831855f, ang); rr = fmaf(-kq, -1.7484555e-7f, rr);
        rc[i] = __cosf(rr); rs[i] = __sinf(rr);
    }
}

DI void norm_row(const float* xr, const float* sc, const float* sh, int lane, f32x4 (&h)[4], bool valid) {
    const f32x4* x4 = (const f32x4*)xr + lane; float ss = 0.f;
#pragma unroll
    for (int j = 0; j < 4; ++j) { h[j] = valid ? x4[64 * j] : (f32x4){0.f, 0.f, 0.f, 0.f}; ss += (h[j].x * h[j].x + h[j].y * h[j].y) + (h[j].z * h[j].z + h[j].w * h[j].w); }
    const float rstd = rsqrtf(wave_sum(ss) * (1.f / D) + 1e-6f);
    const f32x4* sc4 = (const f32x4*)sc + lane; const f32x4* sh4 = (const f32x4*)sh + lane;
#pragma unroll
    for (int j = 0; j < 4; ++j) { const f32x4 s = sc4[64 * j], b = sh4[64 * j]; h[j] = valid ? (h[j] * rstd * (1.f + s) + b) : (f32x4){0.f, 0.f, 0.f, 0.f}; }
}
DI const float* xrow_ptr(KP p, int row, bool from_input) {
    if (from_input) return row < M_CTX ? p->in[0] + (size_t)row * D : p->in[1] + (size_t)(row - M_CTX) * D;
    return p->out + O_X + (size_t)row * D;
}
DI void phase_norm(KP p, const WaveCtx& w, int layer, int which) {
    const float* mod = (const float*)(p->ws + WS_MOD) + (size_t)layer * 3 * MODW;
    bf16_t* H = (bf16_t*)(p->ws + WS_A);
    const bool from_in = (layer == 0 && which == 0);
    for (int row = w.gw; row < M_ALL; row += w.ngw) {
        const float* mc = mod + cond_of_row(row) * MODW + which * 3 * D;
        const float* xr = xrow_ptr(p, row, from_in);
        f32x4 h[4];
        if (from_in) { const f32x4* x4 = (const f32x4*)xr + w.lane; f32x4* o4 = (f32x4*)(p->out + O_X + (size_t)row * D) + w.lane;
#pragma unroll
            for (int j = 0; j < 4; ++j) o4[64 * j] = x4[64 * j]; }
        norm_row(xr, mc + D, mc, w.lane, h, true);
        u32x2* o = (u32x2*)(H + (size_t)row * D) + w.lane;
#pragma unroll
        for (int j = 0; j < 4; ++j) { u32x2 v; v.x = cvtpk(h[j].x, h[j].y); v.y = cvtpk(h[j].z, h[j].w); o[64 * j] = v; }
    }
}
DI void phase_norm_rwkv(KP p, const WaveCtx& w, int layer) {
    const float* mod = (const float*)(p->ws + WS_MOD) + (size_t)layer * 3 * MODW;
    bf16_t* A2 = (bf16_t*)(p->ws + WS_A);
    for (int row = w.gw; row < M_ALL; row += w.ngw) {
        const float* mc = mod + cond_of_row(row) * MODW;
        int t, T; if (row < M_CTX) { t = row & 255; T = T_CTX; } else { t = (row - M_CTX) & 2047; T = T_LAT; }
        const float* xr = p->out + O_X + (size_t)row * D;
        f32x4 hc[4], hp[4], hn[4];
        norm_row(xr, mc + D, mc, w.lane, hc, true);
        norm_row(xr - D, mc + D, mc, w.lane, hp, t > 0);
        norm_row(t < T - 1 ? xr + D : xr, mc + D, mc, w.lane, hn, t < T - 1);
        u32x2* o = (u32x2*)(A2 + (size_t)row * 2048) + w.lane;
#pragma unroll
        for (int j = 0; j < 4; ++j) {
            u32x2 v; v.x = cvtpk(hc[j].x, hc[j].y); v.y = cvtpk(hc[j].z, hc[j].w); o[64 * j] = v;
            const f32x4 xx = 0.5f * (hp[j] + hn[j]) - hc[j];
            u32x2 q; q.x = cvtpk(xx.x, xx.y); q.y = cvtpk(xx.z, xx.w); o[256 + 64 * j] = q;
        }
    }
}

struct AttnCfg {
    int ldq;
    int nq, nk;
    int vw;
    int dv, nvh;
    int kl, j;
    const float *qn, *kn;
    float *kout, *vout;
    const float *ck, *cv;
};
DI AttnCfg make_cfg(KP p, int kind, int j) {
    AttnCfg c;
    if (kind == 0) { c.ldq = 3072; c.nq = 16; c.nk = 16; c.vw = 1024; c.dv = 128; c.nvh = 8; c.kl = 2; c.j = j; c.qn = p->in[14] + j * 64; c.kn = p->in[15] + j * 64;
        c.kout = p->out + O_DAK; c.vout = p->out + O_DAV; c.ck = p->in[2]; c.cv = p->in[3]; }
    else { c.ldq = 1536; c.nq = 16; c.nk = 4; c.vw = 256; c.dv = 64; c.nvh = 4; c.kl = 1; c.j = 0; c.qn = p->in[36]; c.kn = p->in[37];
        c.kout = p->out + O_SWK; c.vout = p->out + O_SWV; c.ck = p->in[5]; c.cv = p->in[6]; }
    return c;
}

DI void phase_qkprep(KP p, const WaveCtx& w, const AttnCfg& c, LAS unsigned char* lds_wave) {
    bf16_t* QKV = (bf16_t*)(p->ws + WS_QKV); bf16_t* Kf = (bf16_t*)(p->ws + WS_KF);
    const float* rc = (const float*)(p->ws + WS_ROPE); const float* rs = rc + 2048 * 32;
    const int lane = w.lane, g = lane >> 1, half = lane & 1;
    const int ng = c.nq + c.nk;
    for (int row = w.gw; row < M_ALL; row += w.ngw) {
        const bool lat = row >= M_CTX; const int tl = lat ? ((row - M_CTX) & 2047) : 0;
        const int b = row >> 8, t = row & 255;
        if (g < ng) {
            const bool isq = g < c.nq;
            const int col = (isq ? g * 64 : 1024 + (g - c.nq) * 64) + half * 32;
            bf16_t* src = QKV + (size_t)row * c.ldq + col;
            float v[32]; float ss = 0.f;
#pragma unroll
            for (int q4 = 0; q4 < 4; ++q4) { const u32x4 wv = *(const u32x4*)(src + 8 * q4); float f[8]; unpack8(wv, f);
#pragma unroll
                for (int e = 0; e < 8; ++e) { v[8 * q4 + e] = f[e]; ss += f[e] * f[e]; } }
            ss = sum2(ss);
            const float rstd = rsqrtf(ss * (1.f / 64.f) + 1e-6f);
            const float* gn = (isq ? c.qn : c.kn) + half * 32;
#pragma unroll
            for (int e = 0; e < 32; ++e) v[e] = v[e] * rstd * gn[e];
            if (lat) {
                const float* cp = rc + tl * 32; const float* sp = rs + tl * 32;
#pragma unroll
                for (int e = 0; e < 32; ++e) { const float pr = dpp_mov<0xB1>(v[e]); const float cs = cp[e], sn = sp[e]; v[e] = half ? (v[e] * cs + pr * sn) : (v[e] * cs - pr * sn); }
            }
            if (!isq && !lat) {
                float* ko = c.kout + ((size_t)(b * c.kl + c.j) * 256 + t) * (c.nk * 64) + (g - c.nq) * 64 + half * 32;
#pragma unroll
                for (int q4 = 0; q4 < 8; ++q4) *(f32x4*)(ko + 4 * q4) = (f32x4){v[4 * q4], v[4 * q4 + 1], v[4 * q4 + 2], v[4 * q4 + 3]};
            }
            if (isq) {
#pragma unroll
                for (int q4 = 0; q4 < 4; ++q4) { float f[8];
#pragma unroll
                    for (int e = 0; e < 8; ++e) f[e] = v[8 * q4 + e] * QSCALE;
                    *(u32x4*)(src + 8 * q4) = pack8(f); }
            } else {
                bf16_t* kd = Kf + ((size_t)(row >> 5) * c.nk + (g - c.nq)) * 2048 + (row & 31) * 8;
#pragma unroll
                for (int q4 = 0; q4 < 4; ++q4) { float f[8];
#pragma unroll
                    for (int e = 0; e < 8; ++e) f[e] = v[8 * q4 + e];
                    *(u32x4*)(kd + (half * 2 + (q4 >> 1)) * 512 + (q4 & 1) * 256) = pack8(f); }
            }
        }
        if (!lat) {
            const bf16_t* vs = QKV + (size_t)row * c.ldq + 1024 + c.nk * 64;
            float* vo = c.vout + ((size_t)(b * c.kl + c.j) * 256 + t) * c.vw;
            for (int i = lane * 4; i < c.vw; i += 256) { const u32x2 wv = *(const u32x2*)(vs + i); *(f32x4*)(vo + i) = (f32x4){bflo(wv.x), bfhi(wv.x), bflo(wv.y), bfhi(wv.y)}; }
        }
    }
    {
        const int kw = c.nk * 64; bf16_t* Kc = (bf16_t*)(p->ws + WS_KC);
        const int n8 = 2 * 256 * kw / 8;
        for (int i = w.gw * 64 + lane; i < n8; i += w.ngw * 64) {
            const int r = (i * 8) / kw, cc = (i * 8) % kw; const int b = r >> 8, t = r & 255;
            const float* s = c.ck + ((size_t)(b * c.kl + c.j) * 256 + t) * kw + cc;
            const f32x4 a = *(const f32x4*)s, bq = *(const f32x4*)(s + 4);
            u32x4 o; o.x = cvtpk(a.x, a.y); o.y = cvtpk(a.z, a.w); o.z = cvtpk(bq.x, bq.y); o.w = cvtpk(bq.z, bq.w);
            const int gk = cc >> 6, cl = cc & 63;
            *(u32x4*)(Kc + ((size_t)(r >> 5) * c.nk + gk) * 2048 + (cl >> 4) * 512 + ((cl >> 3) & 1) * 256 + (r & 31) * 8) = o;
        }
    }
    {
        LAS bf16_t* T = (LAS bf16_t*)lds_wave; const int pitch = c.dv + 2;
        bf16_t* VtC = (bf16_t*)(p->ws + WS_VTC); bf16_t* VtL = (bf16_t*)(p->ws + WS_VTL);
        const int n_ctx = 32 * 8 * c.nvh, n_lat = 2 * 64 * c.nvh, n_cache = 2 * 8 * c.nvh, ntile = n_ctx + n_lat + n_cache;
        const int cpr = c.dv / 8;
        for (int tile = w.gw; tile < ntile; tile += w.ngw) {
            int vh, blk, seq, kindt; int r = tile;
            if (r < n_ctx) { kindt = 0; vh = r % c.nvh; r /= c.nvh; blk = r % 8; seq = r / 8; }
            else if (r < n_ctx + n_lat) { r -= n_ctx; kindt = 1; vh = r % c.nvh; r /= c.nvh; blk = r % 64; seq = r / 64; }
            else { r -= n_ctx + n_lat; kindt = 2; vh = r % c.nvh; r /= c.nvh; blk = r % 8; seq = r / 8; }
            for (int ch = lane; ch < 32 * cpr; ch += 64) {
                const int tr = ch / cpr, cc = (ch % cpr) * 8; u32x4 wv;
                if (kindt == 2) { const float* s = c.cv + ((size_t)(seq * c.kl + c.j) * 256 + blk * 32 + tr) * c.vw + vh * c.dv + cc;
                    const f32x4 a = *(const f32x4*)s, bq = *(const f32x4*)(s + 4); wv.x = cvtpk(a.x, a.y); wv.y = cvtpk(a.z, a.w); wv.z = cvtpk(bq.x, bq.y); wv.w = cvtpk(bq.z, bq.w); }
                else { const int row = (kindt == 0 ? seq * 256 : M_CTX + seq * 2048) + blk * 32 + tr;
                    wv = *(const u32x4*)(QKV + (size_t)row * c.ldq + 1024 + c.nk * 64 + vh * c.dv + cc); }
                LAS unsigned* d = (LAS unsigned*)(T + tr * pitch + cc);
                d[0] = wv.x; d[1] = wv.y; d[2] = wv.z; d[3] = wv.w;
            }
            asm volatile("s_waitcnt lgkmcnt(0)" ::: "memory");
            bf16_t* dst;
            if (kindt == 0) dst = VtC + (size_t)((seq * c.nvh + vh) * c.dv) * 256 + (size_t)blk * 32 * c.dv;
            else dst = VtL + (size_t)((seq * c.nvh + vh) * c.dv) * 2304 + (size_t)((kindt == 1 ? 8 : 0) + blk) * 32 * c.dv;
            for (int id = lane; id < c.dv * 4; id += 64) {
                const int r = id & 31, hi = (id >> 5) & 1, sl = (id >> 6) & 1, d = (id >> 7) * 32 + r;
                unsigned short e[8];
#pragma unroll
                for (int q = 0; q < 8; ++q) { const int kv = 16 * sl + 8 * (q >> 2) + 4 * hi + (q & 3); e[q] = T[kv * pitch + d]; }
                u32x4 o; o.x = e[0] | ((unsigned)e[1] << 16); o.y = e[2] | ((unsigned)e[3] << 16); o.z = e[4] | ((unsigned)e[5] << 16); o.w = e[6] | ((unsigned)e[7] << 16);
                *(u32x4*)(dst + (size_t)id * 8) = o;
            }
            asm volatile("s_waitcnt lgkmcnt(0)" ::: "memory");
        }
    }
}

#define MFMA32(a, b, c) __builtin_amdgcn_mfma_f32_32x32x16_bf16((a), (b), (c), 0, 0, 0)
DI int crow(int r, int hi) { return (r & 3) + 8 * (r >> 2) + 4 * hi; }

template <int NDT, bool MASK>
DI void attn_seg(f32x16 (&o)[NDT], float& m, float& l, const bf16x8 (&qr)[4], const bf16_t* K, int kts, const bf16_t* Vt, int ntiles, int lane, int hi, int qpos, int kpos0) {
    const bf16_t* kp = K + lane * 8;
    const bf16_t* vp = Vt + lane * 8;
    bf16x8 kf[4];
#pragma unroll
    for (int d0 = 0; d0 < 4; ++d0) kf[d0] = *(const bf16x8*)(kp + 512 * d0);
    for (int t = 0; t < ntiles; ++t) {
        bf16x8 vf[NDT][2];
#pragma unroll
        for (int dt = 0; dt < NDT; ++dt) { vf[dt][0] = *(const bf16x8*)(vp + (size_t)(t * NDT + dt) * 1024); vf[dt][1] = *(const bf16x8*)(vp + (size_t)(t * NDT + dt) * 1024 + 512); }
        f32x16 pr;
#pragma unroll
        for (int r = 0; r < 16; ++r) pr[r] = 0.f;
#pragma unroll
        for (int d0 = 0; d0 < 4; ++d0) pr = MFMA32(kf[d0], qr[d0], pr);
        if (t + 1 < ntiles) {
            const bf16_t* kn = kp + (size_t)(t + 1) * kts;
#pragma unroll
            for (int d0 = 0; d0 < 4; ++d0) kf[d0] = *(const bf16x8*)(kn + 512 * d0);
        }
        if (MASK) {
#pragma unroll
            for (int r = 0; r < 16; ++r) { const int dl = kpos0 + t * 32 + crow(r, hi) - qpos; if (dl > 128 || dl < -128) pr[r] = -1e30f; }
        }
        float mx = fmaxf(fmaxf(pr[0], pr[1]), fmaxf(pr[2], pr[3]));
#pragma unroll
        for (int r = 4; r < 16; r += 4) mx = fmaxf(mx, fmaxf(fmaxf(pr[r], pr[r + 1]), fmaxf(pr[r + 2], pr[r + 3])));
        mx = fmaxf(mx, __shfl_xor(mx, 32));
        if (__builtin_amdgcn_ballot_w64(mx > m) != 0ull) {
            const float mn = fmaxf(m, mx);
            const float alpha = __builtin_amdgcn_exp2f(m - mn);
            m = mn; l *= alpha;
#pragma unroll
            for (int dt = 0; dt < NDT; ++dt)
#pragma unroll
                for (int r = 0; r < 16; ++r) o[dt][r] *= alpha;
        }
        float rsum = 0.f;
#pragma unroll
        for (int r = 0; r < 16; ++r) { pr[r] = __builtin_amdgcn_exp2f(pr[r] - m); rsum += pr[r]; }
        l += rsum;
        bf16x8 pb[2];
#pragma unroll
        for (int s = 0; s < 2; ++s) { u32x4 wv; wv.x = cvtpk(pr[8 * s], pr[8 * s + 1]); wv.y = cvtpk(pr[8 * s + 2], pr[8 * s + 3]); wv.z = cvtpk(pr[8 * s + 4], pr[8 * s + 5]); wv.w = cvtpk(pr[8 * s + 6], pr[8 * s + 7]); pb[s] = __builtin_bit_cast(bf16x8, wv); }
#pragma unroll
        for (int dt = 0; dt < NDT; ++dt) {
            o[dt] = MFMA32(vf[dt][0], pb[0], o[dt]); o[dt] = MFMA32(vf[dt][1], pb[1], o[dt]);
        }
    }
}
DI void load_q(bf16x8 (&qr)[4], const bf16_t* Q, int ldq, int r32, int hi) {
#pragma unroll
    for (int d0 = 0; d0 < 4; ++d0) qr[d0] = *(const bf16x8*)(Q + (size_t)r32 * ldq + 16 * d0 + 8 * hi);
}
template <int NDT> DI void zero_o(f32x16 (&o)[NDT]) {
#pragma unroll
    for (int dt = 0; dt < NDT; ++dt)
#pragma unroll
        for (int r = 0; r < 16; ++r) o[dt][r] = 0.f;
}

DI void da_unit(KP p, int layer, bool is_lat, int b, int h, int qb, int lane, float lam, float lam_init, LAS float* osm, int mpsel) {
    const int j = layer / 3;
    const bf16_t* QKV = (const bf16_t*)(p->ws + WS_QKV); const bf16_t* Kc = (const bf16_t*)(p->ws + WS_KC); const bf16_t* Kf = (const bf16_t*)(p->ws + WS_KF);
    const bf16_t* VtC = (const bf16_t*)(p->ws + WS_VTC); const bf16_t* VtL = (const bf16_t*)(p->ws + WS_VTL);
    bf16_t* AO = (bf16_t*)(p->ws + WS_AO);
    const int row0 = (is_lat ? M_CTX + b * 2048 : b * 256) + qb * 32;
    const int seq0 = is_lat ? M_CTX + b * 2048 : b * 256;
    f32x16 o2[4];
    const int mp_lo = mpsel < 0 ? 0 : mpsel, mp_hi = mpsel < 0 ? 2 : mpsel + 1;
#pragma unroll 1
    for (int mp = mp_lo; mp < mp_hi; ++mp) {
        int r32 = lane & 31, hi = lane >> 5; asm volatile("" : "+v"(r32), "+v"(hi));
        bf16x8 qr[4]; load_q(qr, QKV + (size_t)row0 * 3072 + h * 128 + mp * 64, 3072, r32, hi);
        float m = -1e30f, l = 0.f; zero_o<4>(o2);
        const int gsel = h * 2 + mp;
        if (is_lat) {
            const bf16_t* vt = VtL + (size_t)((b * 8 + h) * 128) * 2304;
            attn_seg<4, false>(o2, m, l, qr, Kc + ((size_t)(b * 8) * 16 + gsel) * 2048, 16 * 2048, vt, 8, lane, hi, 0, 0);
            attn_seg<4, false>(o2, m, l, qr, Kf + ((size_t)(seq0 >> 5) * 16 + gsel) * 2048, 16 * 2048, vt + 8 * 4096, 64, lane, hi, 0, 0);
        } else {
            attn_seg<4, false>(o2, m, l, qr, Kf + ((size_t)(seq0 >> 5) * 16 + gsel) * 2048, 16 * 2048, VtC + (size_t)((b * 8 + h) * 128) * 256, 8, lane, hi, 0, 0);
        }
        l += __shfl_xor(l, 32);
        const float il = 1.f / l;
        if (mpsel < 0) {
            if (mp == 0) {
#pragma unroll
                for (int dt = 0; dt < 4; ++dt)
#pragma unroll
                    for (int r = 0; r < 16; ++r) osm[(dt * 16 + r) * 64 + lane] = o2[dt][r] * il;
            } else {
#pragma unroll
                for (int dt = 0; dt < 4; ++dt)
#pragma unroll
                    for (int r = 0; r < 16; ++r) o2[dt][r] = osm[(dt * 16 + r) * 64 + lane] - lam * o2[dt][r] * il;
            }
        } else {
#pragma unroll
            for (int dt = 0; dt < 4; ++dt)
#pragma unroll
                for (int r = 0; r < 16; ++r) o2[dt][r] *= il;
        }
    }
    if (mpsel == 1) {
#pragma unroll
        for (int dt = 0; dt < 4; ++dt)
#pragma unroll
            for (int r = 0; r < 16; ++r) osm[(dt * 16 + r) * 64 + lane] = o2[dt][r];
    }
    if (mpsel >= 0) {
        asm volatile("s_waitcnt lgkmcnt(0)\n\ts_barrier" ::: "memory");
        if (mpsel == 1) return;
#pragma unroll
        for (int dt = 0; dt < 4; ++dt)
#pragma unroll
            for (int r = 0; r < 16; ++r) o2[dt][r] -= lam * osm[(dt * 16 + r) * 64 + lane];
    }
    f32x16 (&o1)[4] = o2;
    int r32 = lane & 31, hi = lane >> 5; asm volatile("" : "+v"(r32), "+v"(hi));
    float ss = 0.f;
#pragma unroll
    for (int dt = 0; dt < 4; ++dt)
#pragma unroll
        for (int r = 0; r < 16; ++r) ss += o1[dt][r] * o1[dt][r];
    ss += __shfl_xor(ss, 32);
    const float sc = rsqrtf(ss * (1.f / 128.f) + 1e-6f) * (1.f - lam_init);
    const float* sg = p->in[17] + j * 128;
    bf16_t* orow = AO + (size_t)(row0 + r32) * D + h * 128;
#pragma unroll
    for (int dt = 0; dt < 4; ++dt)
#pragma unroll
        for (int k4 = 0; k4 < 4; ++k4) {
            const int d = dt * 32 + 8 * k4 + 4 * hi; const f32x4 gq = *(const f32x4*)(sg + d);
            u32x2 wv; wv.x = cvtpk(o1[dt][4 * k4] * sc * gq.x, o1[dt][4 * k4 + 1] * sc * gq.y); wv.y = cvtpk(o1[dt][4 * k4 + 2] * sc * gq.z, o1[dt][4 * k4 + 3] * sc * gq.w);
            *(u32x2*)(orow + d) = wv;
        }
}
DI void phase_attn_da(KP p, int layer, int wave, int lane, LAS float* osm) {
    const int j = layer / 3;
    const float* lp = p->in[16] + j * 256;
    const float s1 = wave_sum(lp[lane] * lp[64 + lane]), s2 = wave_sum(lp[128 + lane] * lp[192 + lane]);
    const float lam_init = 0.8f - 0.6f * expf(-0.3f * (float)layer);
    const float lam = expf(s1) - expf(s2) + lam_init;
    const int G = gridDim.x;
    if (G == 256) {
        const int x = blockIdx.x & 7, slot = blockIdx.x >> 3;
        {
            const int idx = slot * 4 + (wave & 3); const int bh = 2 * x + (idx >> 6), qb = idx & 63;
            da_unit(p, layer, true, bh >> 3, bh & 7, qb, lane, lam, lam_init, osm - (wave >> 2) * 4 * 4096, wave >> 2);
        }
        { const int bh = x * 32 + slot; da_unit(p, layer, false, bh >> 3, bh & 7, wave, lane, lam, lam_init, osm, -1); }
    } else {
        if (wave < 4) { for (int u = blockIdx.x * 4 + wave; u < 1024; u += G * 4) { const int qb = u & 63, bh = u >> 6; da_unit(p, layer, true, bh >> 3, bh & 7, qb, lane, lam, lam_init, osm, -1); } }
        else { for (int u = blockIdx.x * 4 + (wave - 4); u < 2048; u += G * 4) { const int bh = u >> 3, qb = u & 7; da_unit(p, layer, false, bh >> 3, bh & 7, qb, lane, lam, lam_init, osm, -1); } }
    }
}

DI void swa_unit(KP p, bool is_lat, int b, int qh, int qb, int lane) {
    const bf16_t* QKV = (const bf16_t*)(p->ws + WS_QKV); const bf16_t* Kc = (const bf16_t*)(p->ws + WS_KC); const bf16_t* Kf = (const bf16_t*)(p->ws + WS_KF);
    const bf16_t* VtC = (const bf16_t*)(p->ws + WS_VTC); const bf16_t* VtL = (const bf16_t*)(p->ws + WS_VTL);
    bf16_t* AO = (bf16_t*)(p->ws + WS_AO);
    int r32 = lane & 31, hi = lane >> 5; asm volatile("" : "+v"(r32), "+v"(hi));
    const int kvh = qh >> 2;
    const int seq0 = is_lat ? M_CTX + b * 2048 : b * 256;
    const int row0 = seq0 + qb * 32;
    bf16x8 qr[4]; load_q(qr, QKV + (size_t)row0 * 1536 + qh * 64, 1536, r32, hi);
    f32x16 o[2]; zero_o<2>(o); float m = -1e30f, l = 0.f;
    if (is_lat) {
        const bf16_t* vt = VtL + (size_t)((b * 4 + kvh) * 64) * 2304;
        attn_seg<2, false>(o, m, l, qr, Kc + ((size_t)(b * 8) * 4 + kvh) * 2048, 4 * 2048, vt, 8, lane, hi, 0, 0);
        const int q0 = qb * 32; int t0 = q0 - 128; if (t0 < 0) t0 = 0; int t1 = q0 + 160; if (t1 > 2048) t1 = 2048;
        attn_seg<2, true>(o, m, l, qr, Kf + ((size_t)((seq0 + t0) >> 5) * 4 + kvh) * 2048, 4 * 2048, vt + (size_t)(8 + (t0 >> 5)) * 2048, (t1 - t0) >> 5, lane, hi, q0 + r32, t0);
    } else {
        attn_seg<2, false>(o, m, l, qr, Kf + ((size_t)(seq0 >> 5) * 4 + kvh) * 2048, 4 * 2048, VtC + (size_t)((b * 4 + kvh) * 64) * 256, 8, lane, hi, 0, 0);
    }
    l += __shfl_xor(l, 32);
    l += __builtin_amdgcn_exp2f(p->in[38][qh] * LOG2E - m);
    const float il = 1.f / l;
    bf16_t* orow = AO + (size_t)(row0 + r32) * D + qh * 64;
#pragma unroll
    for (int dt = 0; dt < 2; ++dt)
#pragma unroll
        for (int k4 = 0; k4 < 4; ++k4) {
            const int d = dt * 32 + 8 * k4 + 4 * hi;
            u32x2 wv; wv.x = cvtpk(o[dt][4 * k4] * il, o[dt][4 * k4 + 1] * il); wv.y = cvtpk(o[dt][4 * k4 + 2] * il, o[dt][4 * k4 + 3] * il);
            *(u32x2*)(orow + d) = wv;
        }
}
DI void phase_attn_swa(KP p, int wave, int lane) {
    const int G = gridDim.x;
    if (G == 256) {
        const int x = blockIdx.x & 7, slot = blockIdx.x >> 3;
        { const int idx = slot * 8 + wave; const int qh = (x & 3) * 4 + (idx >> 6), qb = idx & 63; swa_unit(p, true, x >> 2, qh, qb, lane); }
        for (int it = 0; it < 2; ++it) { const int pair = x * 64 + slot * 2 + it; swa_unit(p, false, pair >> 4, pair & 15, wave, lane); }
    } else {
        for (int u = blockIdx.x * 8 + wave; u < 2048; u += G * 8) { const int qb = u & 63, bq = u >> 6; swa_unit(p, true, bq >> 4, bq & 15, qb, lane); }
        for (int u = blockIdx.x * 8 + wave; u < 4096; u += G * 8) { const int qb = u & 7, bq = u >> 3; swa_unit(p, false, bq >> 4, bq & 15, qb, lane); }
    }
}

struct ScanRun {
    int row0;
    int h, dir;
    int t_first;
    int nsteps;
    int kind;
    const float* init;
    int init_ident;
    bf16_t* yout;
    float* fin;
};
DI void scan_run(KP p, const ScanRun& R, LAS float* sm, int lane) {
    const bf16_t* RKV = (const bf16_t*)(p->ws + WS_B);
    const bf16_t* E = (const bf16_t*)(p->ws + WS_E) + (size_t)R.dir * M_ALL * D;
    const bf16_t* AA = (const bf16_t*)(p->ws + WS_AA) + (size_t)R.dir * M_ALL * D;
    const int rg = lane >> 3, ks = lane & 7;
    const int st = lane >> 3, cs = lane & 7;
    const int hc = R.h * 64 + cs * 8;
    float kkw[8], kaw[8];
#pragma unroll
    for (int e = 0; e < 8; ++e) { kkw[e] = p->in[29][hc + e]; kaw[e] = p->in[30][hc + e]; }
    f32x2 s[8][4];
#pragma unroll
    for (int i = 0; i < 8; ++i)
#pragma unroll
        for (int q = 0; q < 4; ++q) {
            f32x2 v = {0.f, 0.f};
            if (R.init) v = *(const f32x2*)(R.init + (8 * rg + i) * 64 + 8 * ks + 2 * q);
            else if (R.init_ident) { v.x = (8 * rg + i == 8 * ks + 2 * q) ? 1.f : 0.f; v.y = (8 * rg + i == 8 * ks + 2 * q + 1) ? 1.f : 0.f; }
            s[i][q] = v;
        }
    const int sgn = R.dir ? -1 : 1;
    const int nch = R.nsteps >> 3;
    u32x4 gr, gk, gv, ge, ga;
    auto issue = [&](int c) {
        const int t = R.t_first + sgn * (c * 8 + st);
        const size_t row = (size_t)(R.row0 + t);
        gr = *(const u32x4*)(RKV + row * 3072 + hc); gk = *(const u32x4*)(RKV + row * 3072 + 1024 + hc); gv = *(const u32x4*)(RKV + row * 3072 + 2048 + hc);
        ge = *(const u32x4*)(E + row * D + hc); ga = *(const u32x4*)(AA + row * D + hc);
    };
    issue(0);
    for (int c = 0; c < nch; ++c) {
        {
            float fr[8], fk[8], fv[8], fe[8], fa[8];
            unpack8(gr, fr); unpack8(gk, fk); unpack8(gv, fv); unpack8(ge, fe); unpack8(ga, fa);
            float ss = 0.f; float kk[8];
#pragma unroll
            for (int e = 0; e < 8; ++e) { kk[e] = fk[e] * kkw[e]; ss += kk[e] * kk[e]; }
            ss = sum8(ss);
            const float rn = rsqrtf(fmaxf(ss, 1e-24f));
            LAS float* d = sm + st * 384 + cs * 8;
            f32x4 o0, o1;
#pragma unroll
            for (int e = 0; e < 8; ++e) kk[e] *= rn;
            o0 = (f32x4){-kk[0], -kk[1], -kk[2], -kk[3]}; o1 = (f32x4){-kk[4], -kk[5], -kk[6], -kk[7]}; *(LAS f32x4*)(d) = o0; *(LAS f32x4*)(d + 4) = o1;
            float wv[8];
#pragma unroll
            for (int e = 0; e < 8; ++e) wv[e] = __expf(-fe[e]);
            o0 = (f32x4){wv[0], wv[1], wv[2], wv[3]}; o1 = (f32x4){wv[4], wv[5], wv[6], wv[7]}; *(LAS f32x4*)(d + 64) = o0; *(LAS f32x4*)(d + 68) = o1;
            o0 = (f32x4){kk[0] * fa[0], kk[1] * fa[1], kk[2] * fa[2], kk[3] * fa[3]}; o1 = (f32x4){kk[4] * fa[4], kk[5] * fa[5], kk[6] * fa[6], kk[7] * fa[7]}; *(LAS f32x4*)(d + 128) = o0; *(LAS f32x4*)(d + 132) = o1;
            float kd[8];
#pragma unroll
            for (int e = 0; e < 8; ++e) kd[e] = fk[e] * (1.f + (fa[e] - 1.f) * kaw[e]);
            o0 = (f32x4){kd[0], kd[1], kd[2], kd[3]}; o1 = (f32x4){kd[4], kd[5], kd[6], kd[7]}; *(LAS f32x4*)(d + 192) = o0; *(LAS f32x4*)(d + 196) = o1;
            o0 = (f32x4){fr[0], fr[1], fr[2], fr[3]}; o1 = (f32x4){fr[4], fr[5], fr[6], fr[7]}; *(LAS f32x4*)(d + 256) = o0; *(LAS f32x4*)(d + 260) = o1;
            if (R.kind == 1) { o0 = (f32x4){0.f, 0.f, 0.f, 0.f}; o1 = o0; } else { o0 = (f32x4){fv[0], fv[1], fv[2], fv[3]}; o1 = (f32x4){fv[4], fv[5], fv[6], fv[7]}; }
            *(LAS f32x4*)(d + 320) = o0; *(LAS f32x4*)(d + 324) = o1;
        }
        if (c + 1 < nch) issue(c + 1);
        asm volatile("s_waitcnt lgkmcnt(0)" ::: "memory");
#pragma unroll 2
        for (int q8 = 0; q8 < 8; ++q8) {
            const LAS float* b = sm + q8 * 384;
            f32x2 A[4], W[4], Bv[4], KD[4], Rr[4]; float V[8];
            { const f32x4 x0 = *(const LAS f32x4*)(b + 8 * ks), x1 = *(const LAS f32x4*)(b + 8 * ks + 4); A[0] = (f32x2){x0.x, x0.y}; A[1] = (f32x2){x0.z, x0.w}; A[2] = (f32x2){x1.x, x1.y}; A[3] = (f32x2){x1.z, x1.w}; }
            { const f32x4 x0 = *(const LAS f32x4*)(b + 64 + 8 * ks), x1 = *(const LAS f32x4*)(b + 64 + 8 * ks + 4); W[0] = (f32x2){x0.x, x0.y}; W[1] = (f32x2){x0.z, x0.w}; W[2] = (f32x2){x1.x, x1.y}; W[3] = (f32x2){x1.z, x1.w}; }
            { const f32x4 x0 = *(const LAS f32x4*)(b + 128 + 8 * ks), x1 = *(const LAS f32x4*)(b + 128 + 8 * ks + 4); Bv[0] = (f32x2){x0.x, x0.y}; Bv[1] = (f32x2){x0.z, x0.w}; Bv[2] = (f32x2){x1.x, x1.y}; Bv[3] = (f32x2){x1.z, x1.w}; }
            { const f32x4 x0 = *(const LAS f32x4*)(b + 192 + 8 * ks), x1 = *(const LAS f32x4*)(b + 192 + 8 * ks + 4); KD[0] = (f32x2){x0.x, x0.y}; KD[1] = (f32x2){x0.z, x0.w}; KD[2] = (f32x2){x1.x, x1.y}; KD[3] = (f32x2){x1.z, x1.w}; }
            { const f32x4 x0 = *(const LAS f32x4*)(b + 256 + 8 * ks), x1 = *(const LAS f32x4*)(b + 256 + 8 * ks + 4); Rr[0] = (f32x2){x0.x, x0.y}; Rr[1] = (f32x2){x0.z, x0.w}; Rr[2] = (f32x2){x1.x, x1.y}; Rr[3] = (f32x2){x1.z, x1.w}; }
            { const f32x4 x0 = *(const LAS f32x4*)(b + 320 + 8 * rg), x1 = *(const LAS f32x4*)(b + 320 + 8 * rg + 4); V[0] = x0.x; V[1] = x0.y; V[2] = x0.z; V[3] = x0.w; V[4] = x1.x; V[5] = x1.y; V[6] = x1.z; V[7] = x1.w; }
            float sa[8];
#pragma unroll
            for (int i = 0; i < 8; ++i) { f32x2 a2 = s[i][0] * A[0]; a2 += s[i][1] * A[1]; a2 += s[i][2] * A[2]; a2 += s[i][3] * A[3]; sa[i] = a2.x + a2.y; }
#pragma unroll
            for (int i = 0; i < 8; ++i) sa[i] = sum8(sa[i]);
            float y[8];
#pragma unroll
            for (int i = 0; i < 8; ++i) {
                const f32x2 sa2 = {sa[i], sa[i]}, v2 = {V[i], V[i]};
                f32x2 y2 = {0.f, 0.f};
#pragma unroll
                for (int q = 0; q < 4; ++q) { f32x2 tq = s[i][q] * W[q]; tq += sa2 * Bv[q]; tq += v2 * KD[q]; s[i][q] = tq; y2 += tq * Rr[q]; }
                y[i] = y2.x + y2.y;
            }
            if (R.yout) {
#pragma unroll
                for (int i = 0; i < 8; ++i) y[i] = sum8(y[i]);
                if (ks == 0) {
                    const int t = R.t_first + sgn * (c * 8 + q8);
                    *(u32x4*)(R.yout + (size_t)(R.row0 + t) * D + R.h * 64 + 8 * rg) = pack8(y);
                }
            }
        }
        asm volatile("s_waitcnt lgkmcnt(0)" ::: "memory");
    }
    if (R.fin) {
#pragma unroll
        for (int i = 0; i < 8; ++i) {
            float* fp = R.fin + (8 * rg + i) * 64 + 8 * ks;
            *(f32x4*)(fp) = (f32x4){s[i][0].x, s[i][0].y, s[i][1].x, s[i][1].y}; *(f32x4*)(fp + 4) = (f32x4){s[i][2].x, s[i][2].y, s[i][3].x, s[i][3].y};
        }
    }
}
constexpr int LSEG = 128, NSEG = 16;
DI void lat_scan_ids(int scan, int& b, int& h, int& dir) { b = scan >> 5; h = (scan >> 1) & 15; dir = scan & 1; }
DI void phase_scan1(KP p, LAS float* sm, int wave, int lane) {
    const int gw = blockIdx.x * 8 + wave;
    bf16_t* Y = (bf16_t*)(p->ws + WS_Y); float* SEGF = (float*)(p->ws + WS_SEGF);
    for (int slot = gw; slot < 2048; slot += gridDim.x * 8) {
        if (slot < 1024) {
            const int b = slot >> 5, h = (slot >> 1) & 15, dir = slot & 1;
            ScanRun R; R.row0 = b * 256; R.h = h; R.dir = dir; R.t_first = dir ? 255 : 0; R.nsteps = 256; R.kind = 0; R.init = nullptr; R.init_ident = 0;
            R.yout = Y + (size_t)dir * M_ALL * D; R.fin = p->out + O_RW + (size_t)((b * 2 + dir) * 16 + h) * 4096;
            scan_run(p, R, sm, lane);
        } else {
            for (int sub = 0; sub < 2; ++sub) {
                const int q = (slot - 1024) * 2 + sub; if (q >= 1984) break;
                int scan, seg, kind;
                if (q < 1024) { scan = q >> 4; seg = q & 15; kind = 0; } else { const int q2 = q - 1024; scan = q2 / 15; seg = 1 + q2 % 15; kind = 1; }
                int b, h, dir; lat_scan_ids(scan, b, h, dir);
                ScanRun R; R.row0 = M_CTX + b * 2048; R.h = h; R.dir = dir; R.t_first = dir ? (2047 - LSEG * seg) : LSEG * seg; R.nsteps = LSEG; R.kind = kind;
                R.init = (kind == 0 && seg == 0) ? p->in[4] + (size_t)((b * 2 + dir) * 16 + h) * 4096 : nullptr; R.init_ident = kind;
                R.yout = (kind == 0 && seg == 0) ? Y + (size_t)dir * M_ALL * D : nullptr;
                R.fin = SEGF + ((size_t)(scan * NSEG + seg) * 2 + kind) * 4096;
                scan_run(p, R, sm, lane);
            }
        }
    }
}
DI void phase_combine(KP p, LAS float* sm, const int tid) {
    const float* SEGF = (const float*)(p->ws + WS_SEGF); float* TS = (float*)(p->ws + WS_TS);
    LAS float* smT = sm; LAS float* smP = sm + 4096;
    for (int scan = blockIdx.x; scan < 64; scan += gridDim.x) {
        const int i = tid >> 3, c0 = (tid & 7) * 8;
        float cur[8];
        { const float* L0 = SEGF + ((size_t)(scan * NSEG + 0) * 2 + 0) * 4096 + tid * 8;
#pragma unroll
          for (int e = 0; e < 8; ++e) cur[e] = L0[e]; }
        f32x4 pn0, pn1, ln0, ln1;
        { const float* Pk = SEGF + ((size_t)(scan * NSEG + 1) * 2 + 1) * 4096 + tid * 8; pn0 = *(const f32x4*)Pk; pn1 = *(const f32x4*)(Pk + 4);
          const float* Lk = SEGF + ((size_t)(scan * NSEG + 1) * 2 + 0) * 4096 + tid * 8; ln0 = *(const f32x4*)Lk; ln1 = *(const f32x4*)(Lk + 4); }
        for (int k = 1; k < NSEG; ++k) {
            float* Tk = TS + (size_t)(scan * NSEG + k) * 4096 + tid * 8;
            *(f32x4*)Tk = (f32x4){cur[0], cur[1], cur[2], cur[3]}; *(f32x4*)(Tk + 4) = (f32x4){cur[4], cur[5], cur[6], cur[7]};
            if (k == NSEG - 1) break;
            *(LAS f32x4*)(smT + tid * 8) = (f32x4){cur[0], cur[1], cur[2], cur[3]}; *(LAS f32x4*)(smT + tid * 8 + 4) = (f32x4){cur[4], cur[5], cur[6], cur[7]};
            *(LAS f32x4*)(smP + tid * 8) = pn0; *(LAS f32x4*)(smP + tid * 8 + 4) = pn1;
            float acc[8] = {ln0.x, ln0.y, ln0.z, ln0.w, ln1.x, ln1.y, ln1.z, ln1.w};
            if (k + 1 < NSEG - 1) {
                const float* Pk = SEGF + ((size_t)(scan * NSEG + k + 1) * 2 + 1) * 4096 + tid * 8; pn0 = *(const f32x4*)Pk; pn1 = *(const f32x4*)(Pk + 4);
                const float* Lk = SEGF + ((size_t)(scan * NSEG + k + 1) * 2 + 0) * 4096 + tid * 8; ln0 = *(const f32x4*)Lk; ln1 = *(const f32x4*)(Lk + 4);
            }
            asm volatile("s_waitcnt lgkmcnt(0)\n\ts_barrier" ::: "memory");
#pragma unroll 8
            for (int j = 0; j < 64; ++j) { const float tv = smT[i * 64 + j]; const f32x4 p0 = *(const LAS f32x4*)(smP + j * 64 + c0), p1 = *(const LAS f32x4*)(smP + j * 64 + c0 + 4);
                acc[0] += tv * p0.x; acc[1] += tv * p0.y; acc[2] += tv * p0.z; acc[3] += tv * p0.w; acc[4] += tv * p1.x; acc[5] += tv * p1.y; acc[6] += tv * p1.z; acc[7] += tv * p1.w; }
#pragma unroll
            for (int e = 0; e < 8; ++e) cur[e] = acc[e];
            asm volatile("s_waitcnt lgkmcnt(0)\n\ts_barrier" ::: "memory");
        }
        asm volatile("s_waitcnt lgkmcnt(0)\n\ts_barrier" ::: "memory");
    }
}
DI void phase_scan2(KP p, LAS float* sm, int wave, int lane) {
    bf16_t* Y = (bf16_t*)(p->ws + WS_Y); const float* TS = (const float*)(p->ws + WS_TS);
    if (wave >= 4) return;
    for (int q2 = blockIdx.x * 4 + wave; q2 < 960; q2 += gridDim.x * 4) {
        const int scan = q2 / 15, seg = 1 + q2 % 15; int b, h, dir; lat_scan_ids(scan, b, h, dir);
        ScanRun R; R.row0 = M_CTX + b * 2048; R.h = h; R.dir = dir; R.t_first = dir ? (2047 - LSEG * seg) : LSEG * seg; R.nsteps = LSEG; R.kind = 0;
        R.init = TS + (size_t)(scan * NSEG + seg) * 4096; R.init_ident = 0; R.yout = Y + (size_t)dir * M_ALL * D; R.fin = nullptr;
        scan_run(p, R, sm, lane);
    }
}
DI void phase_rwkv_post(KP p, const WaveCtx& w) {
    const bf16_t* RKV = (const bf16_t*)(p->ws + WS_B); const bf16_t* AA = (const bf16_t*)(p->ws + WS_AA); const bf16_t* Y = (const bf16_t*)(p->ws + WS_Y);
    const bf16_t* Gt = (const bf16_t*)(p->ws + WS_RG); bf16_t* AO = (bf16_t*)(p->ws + WS_RAO);
    for (int u = w.gw; u < M_ALL * 2; u += w.ngw) {
        const int row = u >> 1, c0 = (u & 1) * 512 + w.lane * 8;
        float yf[8], yb[8], r[8], k[8], v[8], a0[8], a1[8], g[8];
        unpack8(*(const u32x4*)(Y + (size_t)row * D + c0), yf); unpack8(*(const u32x4*)(Y + (size_t)(M_ALL + row) * D + c0), yb);
        unpack8(*(const u32x4*)(RKV + (size_t)row * 3072 + c0), r); unpack8(*(const u32x4*)(RKV + (size_t)row * 3072 + 1024 + c0), k); unpack8(*(const u32x4*)(RKV + (size_t)row * 3072 + 2048 + c0), v);
        unpack8(*(const u32x4*)(AA + (size_t)row * D + c0), a0); unpack8(*(const u32x4*)(AA + (size_t)(M_ALL + row) * D + c0), a1);
        unpack8(*(const u32x4*)(Gt + (size_t)row * D + c0), g);
        float y[8], sy = 0.f, bo = 0.f;
#pragma unroll
        for (int e = 0; e < 8; ++e) { y[e] = yf[e] + yb[e]; sy += y[e];
            const float ka = p->in[30][c0 + e]; bo += r[e] * p->in[31][c0 + e] * k[e] * (2.f + (a0[e] + a1[e] - 2.f) * ka); }
        const float mu = sum8(sy) * (1.f / 64.f); bo = sum8(bo);
        float sv = 0.f;
#pragma unroll
        for (int e = 0; e < 8; ++e) { y[e] -= mu; sv += y[e] * y[e]; }
        const float rstd = rsqrtf(sum8(sv) * (1.f / 64.f) + 64e-5f);
        float o[8];
#pragma unroll
        for (int e = 0; e < 8; ++e) o[e] = (y[e] * rstd * p->in[32][c0 + e] + p->in[33][c0 + e] + bo * v[e]) * g[e];
        *(u32x4*)(AO + (size_t)row * D + c0) = pack8(o);
    }
}

#define GAS __attribute__((address_space(1)))
#define XB_TMO      128
#define XB_XCNT(j)  (256  + 64 * (j))
#define XB_XSUB(j)  (1280 + 64 * (j))
#define XB_XGEN(j)  (2304 + 64 * (j))
#define XB_TOP      3328
#define XB_TOPGEN   3392
#define XCD_BAR_WORDS 3456
#define XB_SPIN_CAP (1u << 18)

__device__ __forceinline__ unsigned xb_ld(unsigned* p)              { return __hip_atomic_load(p, __ATOMIC_RELAXED, __HIP_MEMORY_SCOPE_AGENT); }
__device__ __forceinline__ unsigned xb_add(unsigned* p, unsigned v) { return __hip_atomic_fetch_add(p, v, __ATOMIC_RELAXED, __HIP_MEMORY_SCOPE_AGENT); }
__device__ __forceinline__ unsigned xb_xcc_id() { return (unsigned)__builtin_amdgcn_s_getreg((3 << 11) | 20) & 0xFu; }
#define XB_SPIN(cond, bar) do { unsigned _sp = 0; while (cond) { __builtin_amdgcn_s_sleep(1); \
    if ((++_sp & 255u) == 0u) { if (xb_ld(&(bar)[XB_TMO])) break; if (_sp > XB_SPIN_CAP) { atomicAdd(&(bar)[XB_TMO], 1u); break; } } } } while (0)

struct XcdBarrier {
    unsigned* bar; unsigned x;
    volatile LAS unsigned* st;
};

__device__ __forceinline__ XcdBarrier xcd_barrier_post(unsigned* bar, volatile LAS unsigned* st) {
    XcdBarrier b; b.bar = bar; b.x = xb_xcc_id(); b.st = st;
    if (threadIdx.x == 0) (void)xb_add(&bar[XB_XCNT(b.x)], 1u);
    return b;
}
__device__ __forceinline__ void xcd_barrier_complete(unsigned* bar, unsigned x, unsigned& nloc, unsigned& nx) {
    const unsigned G = gridDim.x * gridDim.y * gridDim.z;
    unsigned sum, cnt, mine, sp = 0u;
    for (;;) {
        sum = 0u; cnt = 0u; mine = 0u;
#pragma unroll
        for (unsigned j = 0; j < 16; ++j) { const unsigned c = xb_ld(&bar[XB_XCNT(j)]); sum += c; cnt += (c > 0u) ? 1u : 0u; mine = (j == x) ? c : mine; }
        if (sum == G) break;
        __builtin_amdgcn_s_sleep(1);
        if ((++sp & 255u) == 0u) { if (xb_ld(&bar[XB_TMO])) break; if (sp > XB_SPIN_CAP) { atomicAdd(&bar[XB_TMO], 1u); break; } }
    }
    nloc = mine > 0u ? mine : 1u; nx = cnt > 0u ? cnt : 1u;
}

__device__ __forceinline__ void xcd_barrier(const XcdBarrier& b) {
    asm volatile("s_waitcnt vmcnt(0)" ::: "memory");
    __syncthreads();
    if (threadIdx.x == 0) {
        unsigned* bar = b.bar;
        __builtin_amdgcn_s_waitcnt(0);
        unsigned nloc = b.st[0], nx = b.st[1];
        if (nloc == 0u) { xcd_barrier_complete(bar, b.x, nloc, nx); b.st[0] = nloc; b.st[1] = nx; }
        const unsigned old = xb_add(&bar[XB_XSUB(b.x)], 1u);
        const unsigned gen = old / nloc;
        if (old + 1u == (gen + 1u) * nloc) {
            __builtin_amdgcn_fence(__ATOMIC_RELEASE, "agent");
            asm volatile("s_waitcnt vmcnt(0)" ::: "memory");
            const unsigned og = xb_add(&bar[XB_TOP], 1u);
            const unsigned tg = og / nx;
            if (og + 1u == (tg + 1u) * nx) xb_add(&bar[XB_TOPGEN], 1u);
            else XB_SPIN(xb_ld(&bar[XB_TOPGEN]) == tg, bar);
            __builtin_amdgcn_fence(__ATOMIC_ACQUIRE, "agent");
            xb_add(&bar[XB_XGEN(b.x)], 1u);
            asm volatile("s_waitcnt vmcnt(0)" ::: "memory");
        } else {
            XB_SPIN(xb_ld(&bar[XB_XGEN(b.x)]) == gen, bar);
            __builtin_amdgcn_fence(__ATOMIC_ACQUIRE, "agent");
            asm volatile("s_waitcnt vmcnt(0)" ::: "memory");
        }
    }
    __syncthreads();
}


constexpr int LDS_BYTES = 147456;
constexpr int NPHASES = 37;
constexpr int LDS_BST = 139264;

#ifndef REPMASK
#define REPMASK 0
#endif
#ifndef N_LAUNCH_MODE
#define N_LAUNCH_MODE 1
#endif
enum Op { OP_P0 = 0, OP_NORM, OP_GEMM_QKV, OP_QKPREP, OP_ATTN, OP_GEMM_WO, OP_NORM_R, OP_GEMM_S1, OP_GEMM_S2A, OP_GEMM_S2B, OP_SCAN1, OP_COMBINE, OP_SCAN2, OP_POST, OP_NORM_MLP, OP_GEMM_UP, OP_GEMM_DOWN };
#ifndef PHMASK
#define PHMASK 0xFFFFFFFFu
#endif
__host__ __device__ inline void decode_phase(int pc, int& layer, int& op) {
    if (pc == 0) { layer = 0; op = OP_P0; return; }
    int r = pc - 1;
    if (r < 8) layer = 0; else if (r < 20) { layer = 1; r -= 8; } else if (r < 28) { layer = 2; r -= 20; } else { layer = 3; r -= 28; }
    if (layer != 1) { op = (r < 5) ? (OP_NORM + r) : (OP_NORM_MLP + (r - 5)); }
    else { op = (r < 8) ? (OP_NORM_R + r) : (r == 8 ? OP_GEMM_WO : OP_NORM_MLP + (r - 9)); }
}
DI void run_op(KP p, int layer, int op, LAS unsigned char* lds, const int tid) {
        const int lane = tid & 63, wave = __builtin_amdgcn_readfirstlane(tid >> 6);
        WaveCtx w; w.gw = blockIdx.x * 8 + wave; w.ngw = gridDim.x * 8; w.lane = lane; w.scr = (LAS float*)(lds + wave * 16384);
        const int kind = layer % 3, j = layer / 3;
        const float* modl = (const float*)(p->ws + WS_MOD) + (size_t)layer * 3 * MODW;
        int gk = 0;
        const bf16_t* gA = nullptr; const bf16_t* gB = nullptr; int lda = 0, ldb = 0, gN = 0, gK = 0;
        EpiAct EA{nullptr, 0, 0, nullptr, 0, nullptr, nullptr}; EpiRes ER{p->out + O_X, nullptr};
        if (!((PHMASK >> op) & 1u)) op = -1;
        switch (op) {
        case OP_P0: phase_mod(p, lds, tid); convert_mixer_weights(p, w, 0); break;
        case OP_NORM: if (layer > 0) convert_mixer_weights(p, w, layer); phase_norm(p, w, layer, 0); break;
        case OP_GEMM_QKV: { const int ldq = kind == 0 ? 3072 : 1536; gk = 1; gA = (const bf16_t*)(p->ws + WS_A); lda = D; gB = (const bf16_t*)(p->ws + WS_WQKVT); ldb = D; gN = ldq; gK = D;
            EA.O = (bf16_t*)(p->ws + WS_QKV); EA.ldc = ldq; EA.mode = 0; } break;
        case OP_QKPREP: { const AttnCfg cfg = make_cfg(p, kind, j); phase_qkprep(p, w, cfg, lds + wave * 16384); } break;
        case OP_ATTN: if (kind == 0) phase_attn_da(p, layer, wave, lane, (LAS float*)(lds + wave * 16384)); else phase_attn_swa(p, wave, lane); break;
        case OP_GEMM_WO: gk = 2; gA = (const bf16_t*)(p->ws + (kind == 1 ? WS_RAO : WS_AO)); lda = D; gB = (const bf16_t*)(p->ws + (kind == 1 ? WS_RWO : WS_WOT)); ldb = D; gN = D; gK = D; ER.gate3 = modl + 2 * D; break;
        case OP_NORM_R: convert_mixer_weights(p, w, layer); phase_norm_rwkv(p, w, layer); break;
        case OP_GEMM_S1: gk = 1; gA = (const bf16_t*)(p->ws + WS_A); lda = 2048; gB = (const bf16_t*)(p->ws + WS_S1T); ldb = 2048; gN = 3584; gK = 2048;
            EA.O = (bf16_t*)(p->ws + WS_B); EA.ldc = 3072; EA.mode = 2; EA.O2 = (bf16_t*)(p->ws + WS_LORA); EA.ldc2 = 512; break;
        case OP_GEMM_S2A: gk = 1; gA = (const bf16_t*)(p->ws + WS_LORA); lda = 512; gB = (const bf16_t*)(p->ws + WS_S2T); ldb = 256; gN = 4096; gK = 256;
            EA.O = (bf16_t*)(p->ws + WS_E); EA.ldc = D; EA.mode = 3; EA.O2 = (bf16_t*)(p->ws + WS_AA); EA.ldc2 = D; EA.b0 = p->in[21]; EA.b1 = p->in[24]; break;
        case OP_GEMM_S2B: gk = 1; gA = (const bf16_t*)(p->ws + WS_LORA) + 256; lda = 512; gB = (const bf16_t*)(p->ws + WS_G2T); ldb = 256; gN = D; gK = 256;
            EA.O = (bf16_t*)(p->ws + WS_RG); EA.ldc = D; EA.mode = 0; break;
        case OP_SCAN1: phase_scan1(p, (LAS float*)(lds + wave * 12288), wave, lane); break;
        case OP_COMBINE: phase_combine(p, (LAS float*)lds, tid); break;
        case OP_SCAN2: phase_scan2(p, (LAS float*)(lds + wave * 12288), wave, lane); break;
        case OP_POST: phase_rwkv_post(p, w); break;
        case OP_NORM_MLP: convert_mlp_weights(p, w, layer); phase_norm(p, w, layer, 1); break;
        case OP_GEMM_UP: gk = 1; gA = (const bf16_t*)(p->ws + WS_A); lda = D; gB = (const bf16_t*)(p->ws + WS_W1T); ldb = D; gN = FFD; gK = D;
            EA.O = (bf16_t*)(p->ws + WS_B); EA.ldc = FFD; EA.mode = 1; break;
        case OP_GEMM_DOWN: gk = 2; gA = (const bf16_t*)(p->ws + WS_B); lda = FFD; gB = (const bf16_t*)(p->ws + WS_W2T); ldb = FFD; gN = D; gK = FFD; ER.gate3 = modl + 5 * D; break;
        default: break;
        }
        if (gk == 1) run_gemm(lds, gA, lda, gB, ldb, gN, gK, EA, tid);
        else if (gk == 2) run_gemm(lds, gA, lda, gB, ldb, gN, gK, ER, tid);
}

#if N_LAUNCH_MODE == 1
__global__ void __launch_bounds__(512, 2) trunk_fwd(Params p_) {
    extern __shared__ __attribute__((aligned(16))) unsigned char lds_raw[];
    LAS unsigned char* lds = (LAS unsigned char*)lds_raw;
    cg::grid_group grid = cg::this_grid();
    const int ph_lo = p_.ph_lo, ph_hi = p_.ph_hi;
    volatile LAS unsigned* bst = (volatile LAS unsigned*)(lds + LDS_BST);
    if (threadIdx.x < 2) bst[threadIdx.x] = 0u;
    __syncthreads();
    XcdBarrier xbar = xcd_barrier_post((unsigned*)(p_.ws + WS_BAR), bst);
    for (int pc = ph_lo; pc < ph_hi; ++pc) {
        KP p = (KP)__builtin_amdgcn_kernarg_segment_ptr(); asm volatile("" : "+s"(p));
        int layer, op; decode_phase(pc, layer, op);
        const int nrep = (((p->repmask >> op) & 1) && ((((p->repmask >> 20) & 0xF) == 0) || ((p->repmask >> (20 + layer)) & 1))) ? 2 : 1;
        for (int rep = 0; rep < nrep; ++rep) {
            int tid = threadIdx.x; asm volatile("" : "+v"(tid));
            run_op(p, layer, op, lds, tid);
        }
        if (pc + 1 < ph_hi) { if (pc == ph_lo) grid.sync(); else xcd_barrier(xbar); }
    }
}
#else
template <int OP> __global__ void __launch_bounds__(512, 2) k_op(Params p_) {
    extern __shared__ __attribute__((aligned(16))) unsigned char lds_raw[];
    KP p = (KP)__builtin_amdgcn_kernarg_segment_ptr();
    run_op(p, p_.ph_lo, OP, (LAS unsigned char*)lds_raw, threadIdx.x);
}

#endif
extern "C" void kernel_launch(void* const* d_in, const int* in_sizes, int n_in, void* d_out, int out_size, void* d_ws, size_t ws_size, hipStream_t stream) {
    static int grid = 0;
    if (grid == 0) {
        if (n_in != 40 || ws_size < WS_END || out_size != 54525952) { fprintf(stderr, "kernel_launch: unexpected problem (n_in %d, ws %zu, out %d)\n", n_in, ws_size, out_size); grid = -1; return; }
        int dev = 0, cus = 0, per_cu = 0;
        if (hipGetDevice(&dev) != hipSuccess || hipDeviceGetAttribute(&cus, hipDeviceAttributeMultiprocessorCount, dev) != hipSuccess) { grid = -1; return; }
#if N_LAUNCH_MODE == 1
        if (hipFuncSetAttribute((const void*)trunk_fwd, hipFuncAttributeMaxDynamicSharedMemorySize, LDS_BYTES) != hipSuccess) { fprintf(stderr, "kernel_launch: hipFuncSetAttribute failed\n"); grid = -1; return; }
        if (hipOccupancyMaxActiveBlocksPerMultiprocessor(&per_cu, (const void*)trunk_fwd, 512, LDS_BYTES) != hipSuccess || per_cu < 1) { fprintf(stderr, "kernel_launch: occupancy query says %d\n", per_cu); grid = -1; return; }
#else
        per_cu = 1;
#endif
        grid = cus * per_cu;
        if (grid > 256) grid = 256;
    }
    if (grid < 0) return;
    if (hipMemsetAsync((char*)d_ws + WS_BAR, 0, 16384, stream) != hipSuccess) { fprintf(stderr, "kernel_launch: memset failed\n"); return; }
    Params p{};
    for (int i = 0; i < 40; ++i) p.in[i] = (const float*)d_in[i];
    p.out = (float*)d_out; p.ws = (unsigned char*)d_ws; p.repmask = REPMASK; p.pad = 0;
#if N_LAUNCH_MODE == 1
    p.ph_lo = 0; p.ph_hi = NPHASES;
    void* args[] = {&p};
    hipError_t e = hipLaunchCooperativeKernel((const void*)trunk_fwd, dim3(grid), dim3(512), args, LDS_BYTES, stream);
    if (e != hipSuccess) fprintf(stderr, "cooperative launch failed: %s (grid %d)\n", hipGetErrorString(e), grid);
#else
    for (int ph = 0; ph < NPHASES; ++ph) {
        int layer, op; decode_phase(ph, layer, op);
        p.ph_lo = layer; p.ph_hi = 0;
#define LOP(X) case X: { static bool once##X = false; if (!once##X) { (void)hipFuncSetAttribute((const void*)k_op<X>, hipFuncAttributeMaxDynamicSharedMemorySize, LDS_BYTES); once##X = true; } hipLaunchKernelGGL(k_op<X>, dim3(grid), dim3(512), LDS_BYTES, stream, p); } break;
        switch (op) { LOP(0) LOP(1) LOP(2) LOP(3) LOP(4) LOP(5) LOP(6) LOP(7) LOP(8) LOP(9) LOP(10) LOP(11) LOP(12) LOP(13) LOP(14) LOP(15) LOP(16) default: break; }
#undef LOP
    }
#endif
}
```

```cpp
#include <hip/hip_runtime.h>
#include <hip/hip_cooperative_groups.h>
#include <cstdio>
#include <cstdint>
namespace cg = cooperative_groups;
#define DI __device__ __forceinline__
namespace pg8 {
#define PG8_LAS __attribute__((address_space(3)))
typedef unsigned short bf16_t;
typedef short bf16x8 __attribute__((ext_vector_type(8)));
typedef float f32x4 __attribute__((ext_vector_type(4)));
typedef unsigned u32x4 __attribute__((ext_vector_type(4)));
constexpr int BM = 256, BK = 64, HALF = 128, HTB = HALF * BK * 2  , STAGE_BYTES = 8 * HTB, NXCD = 8, WGM = 8;

__host__ __device__ __forceinline__ int lds_byte(int r, int c) { const int st = (r >> 4) * 2 + (c >> 5), rr = r & 15, cc = c & 31, ob = rr * 64 + cc * 2; return st * 1024 + (ob ^ (((ob >> 9) & 1) << 5)); }
__host__ __device__ __forceinline__ void stage_rc(int b, int& R, int& C) { const int st = b / 1024, sb = b % 1024, swz = sb ^ (((sb >> 9) & 1) << 5); R = (st >> 1) * 16 + swz / 64; C = (st & 1) * 32 + (swz % 64) / 2; }
__host__ __device__ __forceinline__ int perm32(int rho) { const int n = rho >> 4, i = rho & 15; return 8 * (i >> 2) + 4 * n + (i & 3); }

struct Unit { int pm, pn; };
struct Gemm { const bf16_t* A; const bf16_t* Bt; int lda, ldb, M, N, K; size_t a_gstride; };

struct StaticOrder {
    int nM, nN, nwg, G, c;
    __host__ __device__ void init(int M, int N, int G_, int c_) { nM = M / BM; nN = N / BM; nwg = nM * nN; G = G_; c = c_; }
    __host__ __device__ bool next(int i, Unit& u) const {
        const long L = (long)i * G + c; if (L >= nwg) return false;
        int wgid = (int)L; { const int q = nwg / NXCD, r = nwg % NXCD, xcd = wgid % NXCD, off = wgid / NXCD; wgid = (xcd < r ? xcd * (q + 1) : r * (q + 1) + (xcd - r) * q) + off; }
        const int nig = WGM * nN, gid = wgid / nig, fm = gid * WGM, gsz = (nM - fm) < WGM ? (nM - fm) : WGM;
        u.pm = fm + ((wgid % nig) % gsz); u.pn = (wgid % nig) / gsz; return true;
    }
    __device__ __forceinline__ void a_ready(const Unit&) const {}
    __device__ __forceinline__ void done(const Unit&) const {}
};


template <class Epi, class Sched, bool ALIGN_EPI = false, bool SP2 = false>
__device__ __forceinline__ void gemm_phase(PG8_LAS unsigned char* lds, const Gemm g, const Sched& S, const Epi& E, const int tid) {
    const int wid = __builtin_amdgcn_readfirstlane(tid >> 6), lane = tid & 63, wr = wid >> 2, wc = wid & 3, fr = lane & 15, fq = lane >> 4;
    const int K = g.K, nt = K / BK;
    unsigned voffA[2], voffB[2];
#pragma unroll
    for (int i = 0; i < 2; ++i) { int R, C; stage_rc(tid * 16 + i * 8192, R, C); const int Rb = Epi::PERM ? ((R & ~31) + perm32(R & 31)) : R;
        voffA[i] = (unsigned)(R * g.lda + C) * 2u; voffB[i] = (unsigned)(Rb * g.ldb + C) * 2u; }
    const size_t kstep = (size_t)(BK * 2);
    const size_t hstepA = (size_t)HALF * g.lda * 2, hstepB = (size_t)HALF * g.ldb * 2;
    const size_t tstepA = 2 * hstepA, tstepB = 2 * hstepB;
    const unsigned ldsw = (unsigned)wid * 1024u;
    const int aoff = lds_byte(wr * 64 + fr, fq * 8), boff = lds_byte(wc * 32 + fr, fq * 8);
#define PG8_SA(b, h) (((b) * 2 + (h)) * HTB)
#define PG8_SB(b, h) ((4 + (b) * 2 + (h)) * HTB)
#define PG8_STAGE(bufoff, gbase, voff) do { _Pragma("unroll") for (int _i = 0; _i < 2; ++_i) \
        __builtin_amdgcn_global_load_lds((const unsigned*)((const char*)(gbase) + (voff)[_i]), (PG8_LAS unsigned*)(lds + (bufoff) + ldsw + _i * 8192), 16, 0, 0); } while (0)
#define PG8_LDA(dst, b, h) do { _Pragma("unroll") for (int m = 0; m < 4; ++m) _Pragma("unroll") for (int k = 0; k < 2; ++k) dst[m][k] = *(const PG8_LAS bf16x8*)(lds + PG8_SA(b, h) + aoff + m * 2048 + k * 1024); } while (0)
#define PG8_LDB(dst, b, h) do { _Pragma("unroll") for (int n = 0; n < 2; ++n) _Pragma("unroll") for (int k = 0; k < 2; ++k) dst[n][k] = *(const PG8_LAS bf16x8*)(lds + PG8_SB(b, h) + boff + n * 2048 + k * 1024); } while (0)
#define PG8_MMA(ai, bj, At, Bt) do { __builtin_amdgcn_s_setprio(1); _Pragma("unroll") for (int m = 0; m < 4; ++m) _Pragma("unroll") for (int n = 0; n < 2; ++n) _Pragma("unroll") for (int k = 0; k < 2; ++k) \
        acc[ai][bj][m][n] = __builtin_amdgcn_mfma_f32_16x16x32_bf16(Bt[n][k], At[m][k], acc[ai][bj][m][n], 0, 0, 0); __builtin_amdgcn_s_setprio(0); } while (0)
#define PG8_WAIT_V(n) asm volatile("s_waitcnt vmcnt(" #n ")" ::: "memory")
#define PG8_WAIT_L(n) asm volatile("s_waitcnt lgkmcnt(" #n ")" ::: "memory")
#define PG8_BAR __builtin_amdgcn_s_barrier()
#define PG8_SCHED __builtin_amdgcn_sched_barrier(0)
    Unit cur, nxt; int ui = 0;
    if (!S.next(0, cur)) return;
    f32x4 acc[2][2][4][2];
#pragma unroll
    for (int a = 0; a < 2; ++a)
#pragma unroll
        for (int b = 0; b < 2; ++b)
#pragma unroll
            for (int m = 0; m < 4; ++m)
#pragma unroll
                for (int n = 0; n < 2; ++n) acc[a][b][m][n] = (f32x4){0.f, 0.f, 0.f, 0.f};
    bf16x8 At[4][2], B0[2][2], B1[2][2];
    const char* cA = (const char*)g.A + (size_t)cur.pm * tstepA + (size_t)(cur.pn >> 2) * g.a_gstride; const char* cB = (const char*)g.Bt + (size_t)cur.pn * tstepB;
    S.a_ready(cur);
    if constexpr (SP2) {
        PG8_STAGE(PG8_SB(0, 0), cB, voffB); PG8_STAGE(PG8_SB(0, 1), cB + hstepB, voffB); PG8_STAGE(PG8_SA(0, 0), cA, voffA); PG8_STAGE(PG8_SA(0, 1), cA + hstepA, voffA);
        if (wr == 1) PG8_BAR;
        PG8_WAIT_V(2); PG8_BAR;
        PG8_STAGE(PG8_SB(1, 0), cB + kstep, voffB); PG8_STAGE(PG8_SA(1, 0), cA + kstep, voffA); PG8_STAGE(PG8_SB(1, 1), cB + hstepB + kstep, voffB);
        PG8_WAIT_V(6); PG8_BAR;
    } else {
        PG8_STAGE(PG8_SB(0, 0), cB, voffB); PG8_STAGE(PG8_SA(0, 0), cA, voffA); PG8_STAGE(PG8_SB(0, 1), cB + hstepB, voffB); PG8_STAGE(PG8_SA(0, 1), cA + hstepA, voffA);
        if (wr == 1) PG8_BAR;
        PG8_WAIT_V(4); PG8_BAR;
        PG8_STAGE(PG8_SB(1, 0), cB + kstep, voffB); PG8_STAGE(PG8_SA(1, 0), cA + kstep, voffA); PG8_STAGE(PG8_SB(1, 1), cB + hstepB + kstep, voffB);
        PG8_WAIT_V(6); PG8_BAR;
    }
    for (;;) {
        const bool has_next = S.next(ui + 1, nxt);
        const char* nA = has_next ? (const char*)g.A + (size_t)nxt.pm * tstepA + (size_t)(nxt.pn >> 2) * g.a_gstride : cA; const char* nB = has_next ? (const char*)g.Bt + (size_t)nxt.pn * tstepB : cB;
        for (int t = 0; t < nt; t += 2) {
            const bool last = (t == nt - 2);
            const char* a1 = cA + (size_t)(t + 1) * kstep;
            const char* a2 = last ? nA : cA + (size_t)(t + 2) * kstep; const char* b2 = last ? nB : cB + (size_t)(t + 2) * kstep;
            const char* a3 = a2 + kstep; const char* b3 = b2 + kstep;
            if (last && has_next) S.a_ready(nxt);
            if constexpr (SP2) {
            PG8_LDB(B0, 0, 0); PG8_LDB(B1, 0, 1); PG8_SCHED; PG8_LDA(At, 0, 0); PG8_STAGE(PG8_SA(1, 1), a1 + hstepA, voffA);
            PG8_WAIT_V(8); PG8_WAIT_L(0); PG8_BAR; PG8_MMA(0, 0, At, B0); PG8_MMA(0, 1, At, B1); PG8_BAR; PG8_SCHED;
            PG8_LDA(At, 0, 1); PG8_STAGE(PG8_SB(0, 0), b2, voffB); PG8_STAGE(PG8_SB(0, 1), b2 + hstepB, voffB); PG8_STAGE(PG8_SA(0, 0), a2, voffA);
            PG8_WAIT_V(8); PG8_WAIT_L(0); PG8_BAR; PG8_MMA(1, 0, At, B0); PG8_MMA(1, 1, At, B1); PG8_BAR; PG8_SCHED;
            PG8_LDB(B0, 1, 0); PG8_LDB(B1, 1, 1); PG8_SCHED; PG8_LDA(At, 1, 0); PG8_STAGE(PG8_SA(0, 1), a2 + hstepA, voffA);
            PG8_WAIT_V(8); PG8_WAIT_L(0); PG8_BAR; PG8_MMA(0, 0, At, B0); PG8_MMA(0, 1, At, B1); PG8_BAR; PG8_SCHED;
            PG8_LDA(At, 1, 1); PG8_STAGE(PG8_SB(1, 0), b3, voffB); PG8_STAGE(PG8_SB(1, 1), b3 + hstepB, voffB); PG8_STAGE(PG8_SA(1, 0), a3, voffA);
            PG8_WAIT_V(8); PG8_WAIT_L(0); PG8_BAR; PG8_MMA(1, 0, At, B0); PG8_MMA(1, 1, At, B1); PG8_BAR; PG8_SCHED;
            } else {
            PG8_LDB(B0, 0, 0); PG8_SCHED; PG8_LDA(At, 0, 0); PG8_STAGE(PG8_SA(1, 1), a1 + hstepA, voffA);
            PG8_WAIT_L(8); PG8_BAR; PG8_WAIT_L(0); PG8_MMA(0, 0, At, B0); PG8_BAR; PG8_SCHED;
            PG8_LDB(B1, 0, 1); PG8_STAGE(PG8_SB(0, 0), b2, voffB);
            PG8_BAR; PG8_WAIT_L(0); PG8_MMA(0, 1, At, B1); PG8_BAR;
            PG8_LDA(At, 0, 1); PG8_STAGE(PG8_SA(0, 0), a2, voffA);
            PG8_BAR; PG8_WAIT_L(0); PG8_MMA(1, 0, At, B0); PG8_BAR; PG8_SCHED;
            PG8_STAGE(PG8_SB(0, 1), b2 + hstepB, voffB);
            PG8_WAIT_V(6); PG8_BAR; PG8_MMA(1, 1, At, B1); PG8_BAR;
            PG8_LDB(B0, 1, 0); PG8_SCHED; PG8_LDA(At, 1, 0); PG8_STAGE(PG8_SA(0, 1), a2 + hstepA, voffA);
            PG8_WAIT_L(8); PG8_BAR; PG8_WAIT_L(0); PG8_MMA(0, 0, At, B0); PG8_BAR; PG8_SCHED;
            PG8_LDB(B1, 1, 1); PG8_STAGE(PG8_SB(1, 0), b3, voffB);
            PG8_BAR; PG8_WAIT_L(0); PG8_MMA(0, 1, At, B1); PG8_BAR;
            PG8_LDA(At, 1, 1); PG8_STAGE(PG8_SA(1, 0), a3, voffA);
            PG8_BAR; PG8_WAIT_L(0); PG8_MMA(1, 0, At, B0); PG8_BAR; PG8_SCHED;
            PG8_STAGE(PG8_SB(1, 1), b3 + hstepB, voffB);
            PG8_WAIT_V(6); PG8_BAR; PG8_MMA(1, 1, At, B1); PG8_BAR;
            }
        }
        if constexpr (ALIGN_EPI) { if (wr == 0) PG8_BAR; }
        if constexpr (!Epi::AFTER_DRAIN) { E(acc, cur, wr, wc, fr, fq); S.done(cur); }
        if (!has_next) break;
#pragma unroll
        for (int a = 0; a < 2; ++a)
#pragma unroll
            for (int b = 0; b < 2; ++b)
#pragma unroll
                for (int m = 0; m < 4; ++m)
#pragma unroll
                    for (int n = 0; n < 2; ++n) acc[a][b][m][n] = (f32x4){0.f, 0.f, 0.f, 0.f};
        cur = nxt; cA = nA; cB = nB; ++ui;
        if constexpr (ALIGN_EPI) { if (wr == 1) PG8_BAR; }
    }
    PG8_WAIT_V(0);
    if constexpr (!ALIGN_EPI) { if (wr == 0) PG8_BAR; }
    PG8_BAR;
    if constexpr (Epi::AFTER_DRAIN) { E.fused(acc, cur, wr, wc, fr, fq, lds, wid, lane); S.done(cur); }
#undef PG8_SA
#undef PG8_SB
#undef PG8_STAGE
#undef PG8_LDA
#undef PG8_LDB
#undef PG8_MMA
#undef PG8_WAIT_V
#undef PG8_WAIT_L
#undef PG8_BAR
#undef PG8_SCHED
}
}


#define LAS __attribute__((address_space(3)))
typedef unsigned short bf16_t;
typedef short bf16x8 __attribute__((ext_vector_type(8)));
typedef float f32x4 __attribute__((ext_vector_type(4)));
typedef float f32x2 __attribute__((ext_vector_type(2)));
typedef float f32x16 __attribute__((ext_vector_type(16)));
typedef unsigned u32x4 __attribute__((ext_vector_type(4)));
typedef unsigned u32x2 __attribute__((ext_vector_type(2)));
typedef __bf16 bf16x2_t __attribute__((ext_vector_type(2)));

constexpr int D = 1024, FFD = 4096, M_CTX = 8192, M_LAT = 4096, M_ALL = 12288, T_CTX = 256, T_LAT = 2048, NPAST = 256;
constexpr int MODW = 6144;
constexpr size_t MiB = 1u << 20;
constexpr size_t O_X = 0, O_DAK = 12582912, O_DAV = 29360128, O_RW = 46137344, O_SWK = 50331648, O_SWV = 52428800;
constexpr size_t WS_MOD = 0;
constexpr size_t WS_BAR = 400 * 1024;
constexpr size_t WS_ROPE = 512 * 1024;
constexpr size_t WS_SEGF = 1 * MiB;
constexpr size_t WS_W = 33 * MiB;
constexpr size_t WS_A = 53 * MiB;
constexpr size_t WS_B = 101 * MiB;
constexpr size_t WS_C = 197 * MiB;
constexpr size_t WS_MLPW = 341 * MiB;
constexpr size_t WS_END = 373 * MiB;
DI size_t ws_w1t(int layer) { return WS_MLPW + (size_t)(layer & 1) * 16 * MiB; }
DI size_t ws_w2t(int layer) { return WS_MLPW + (size_t)(layer & 1) * 16 * MiB + 8 * MiB; }
constexpr size_t WS_QKV = WS_B, WS_AO = WS_B + 72 * MiB;
constexpr size_t WS_LORA = WS_B + 72 * MiB;
constexpr size_t WS_RG = WS_A, WS_RAO = WS_A + 24 * MiB, WS_TS = WS_A + 24 * MiB;
constexpr size_t WS_E = WS_C, WS_AA = WS_C + 48 * MiB, WS_Y = WS_C + 96 * MiB;
constexpr size_t WS_XS = WS_C;
constexpr size_t WS_VTC = WS_C, WS_VTL = WS_C + 32 * MiB, WS_KC = WS_C + 48 * MiB, WS_KF = WS_C + 64 * MiB;
constexpr size_t WS_S1T = WS_W;
constexpr size_t WS_S2T = WS_W + 14 * MiB;
constexpr size_t WS_G2T = WS_W + 16 * MiB;
constexpr size_t WS_RWO = WS_W + 17 * MiB;
constexpr size_t WS_WQKVT = WS_W, WS_WOT = WS_W + 8 * MiB;

constexpr float LOG2E = 1.4426950408889634f;
constexpr float QSCALE = 0.125f * LOG2E;

struct Params { const float* in[40]; float* out; unsigned char* ws; int ph_lo, ph_hi, repmask, pad; };
typedef const __attribute__((address_space(4))) Params* KP;

DI unsigned cvtpk(float lo, float hi) { f32x2 v = {lo, hi}; bf16x2_t b = __builtin_convertvector(v, bf16x2_t); return __builtin_bit_cast(unsigned, b); }
DI float bflo(unsigned w) { return __uint_as_float(w << 16); }
DI float bfhi(unsigned w) { return __uint_as_float(w & 0xffff0000u); }
DI float bf2f(bf16_t b) { return __uint_as_float(((unsigned)b) << 16); }
DI void unpack8(const u32x4 w, float (&f)[8]) { f[0] = bflo(w.x); f[1] = bfhi(w.x); f[2] = bflo(w.y); f[3] = bfhi(w.y); f[4] = bflo(w.z); f[5] = bfhi(w.z); f[6] = bflo(w.w); f[7] = bfhi(w.w); }
DI u32x4 pack8(const float (&f)[8]) { u32x4 w; w.x = cvtpk(f[0], f[1]); w.y = cvtpk(f[2], f[3]); w.z = cvtpk(f[4], f[5]); w.w = cvtpk(f[6], f[7]); return w; }
template <int CTRL> DI float dpp_mov(float v) { return __uint_as_float((unsigned)__builtin_amdgcn_update_dpp(0, (int)__float_as_uint(v), CTRL, 0xF, 0xF, true)); }
DI float sum2(float v) { v += dpp_mov<0xB1>(v); return v; }
DI float sum8(float v) { v += dpp_mov<0xB1>(v); v += dpp_mov<0x4E>(v); v += dpp_mov<0x141>(v); return v; }
DI float wave_sum(float v) {
#pragma unroll
    for (int o = 1; o < 64; o <<= 1) v += __shfl_xor(v, o);
    return v;
}
DI float sigmoidf_(float x) { return 1.f / (1.f + __expf(-x)); }
DI int cond_of_row(int row) { return row < M_CTX ? 0 : (row < M_CTX + T_LAT ? 1 : 2); }

struct EpiAct {
    static constexpr bool PERM = true, AFTER_DRAIN = false;
    bf16_t* O; int ldc; int mode; bf16_t* O2; int ldc2; const float* b0; const float* b1; int pn_off;
    DI void operator()(const pg8::f32x4 (&acc)[2][2][4][2], const pg8::Unit& u, int wr, int wc, int fr, int fq) const {
        const int row0 = u.pm * 256 + wr * 64 + fr;
        bf16_t* base = O; int ld = ldc; int colt = u.pn * 256; int act0 = 0, act1 = 0; const float* bias = nullptr; float cmul = 1.f;
        if (mode == 1) { act0 = act1 = 1; }
        else if (mode == 2) { const int pn = u.pn + pn_off; if (pn >= 12) { base = O2; ld = ldc2; colt = (pn - 12) * 256; act0 = (pn == 12) ? 2 : 3; act1 = 0; } }
        else if (mode == 3) { act0 = act1 = 4; if (u.pn < 8) { bias = b0 + u.pn * 256; cmul = 0.6065306597126334f; base = O + (size_t)(u.pn >> 2) * M_ALL * D; colt = (u.pn & 3) * 256; }
                              else { bias = b1 + (u.pn - 8) * 256; base = O2 + (size_t)((u.pn - 8) >> 2) * M_ALL * D; colt = (u.pn & 3) * 256; ld = ldc2; } }
        const int cw = wc * 32 + 8 * fq;
#pragma unroll
        for (int ai = 0; ai < 2; ++ai)
#pragma unroll
            for (int m = 0; m < 4; ++m) {
                bf16_t* rowp = base + (size_t)(row0 + ai * 128 + m * 16) * ld + colt + cw;
#pragma unroll
                for (int bj = 0; bj < 2; ++bj) {
                    const int act = bj ? act1 : act0;
                    float v[8];
#pragma unroll
                    for (int j = 0; j < 4; ++j) { v[j] = acc[ai][bj][m][0][j]; v[4 + j] = acc[ai][bj][m][1][j]; }
                    if (act == 1) {
#pragma unroll
                        for (int j = 0; j < 8; ++j) { const float r = fmaxf(v[j], 0.f); v[j] = r * r; }
                    } else if (act == 2) {
#pragma unroll
                        for (int j = 0; j < 8; ++j) { const float e2 = __expf(2.f * v[j]); v[j] = 1.f - 2.f / (e2 + 1.f); }
                    } else if (act == 3) {
#pragma unroll
                        for (int j = 0; j < 8; ++j) v[j] = sigmoidf_(v[j]);
                    } else if (act == 4) {
                        const float* bp = bias + bj * 128 + cw;
#pragma unroll
                        for (int j = 0; j < 8; ++j) v[j] = cmul * sigmoidf_(v[j] + bp[j]);
                    }
                    *(u32x4*)(rowp + bj * 128) = pack8(v);
                }
            }
    }
};
struct EpiRes {
    static constexpr bool PERM = false, AFTER_DRAIN = false;
    float* X; const float* gate3;
    DI void operator()(const pg8::f32x4 (&acc)[2][2][4][2], const pg8::Unit& u, int wr, int wc, int fr, int fq) const {
        const int cond = u.pm < 32 ? 0 : (u.pm < 40 ? 1 : 2);
        const float* g = gate3 + cond * MODW;
        const int col0 = u.pn * 256 + wc * 32 + 4 * fq, row0 = u.pm * 256 + wr * 64 + fr;
#pragma unroll
        for (int bj = 0; bj < 2; ++bj)
#pragma unroll
            for (int n = 0; n < 2; ++n) {
                const int col = col0 + bj * 128 + n * 16;
                const f32x4 gv = *(const f32x4*)(g + col);
#pragma unroll
                for (int ai = 0; ai < 2; ++ai)
#pragma unroll
                    for (int m = 0; m < 4; ++m) {
                        float* p = X + (size_t)(row0 + ai * 128 + m * 16) * D + col;
                        f32x4 v = *(const f32x4*)p; v += gv * acc[ai][bj][m][n]; *(f32x4*)p = v;
                    }
            }
    }
};

template <class Epi> DI void run_gemm(LAS unsigned char* lds, const bf16_t* A, int lda, const bf16_t* Bt, int ldb, int N, int K, const Epi& E, int tid, size_t a_gstride = 0) {
    pg8::Gemm g{A, Bt, lda, ldb, M_ALL, N, K, a_gstride}; pg8::StaticOrder S; S.init(M_ALL, N, (int)gridDim.x, (int)blockIdx.x);
    pg8::gemm_phase<Epi, pg8::StaticOrder, true, true>(lds, g, S, E, tid);
}

DI void titem(const float* W, int N, bf16_t* dst, int ldt, int nrow0, int kcol0, const float* ks, int kb, int nb, LAS float* scr, int lane) {
    const int k0 = 64 * kb, n0 = 32 * nb;
    const int c = lane & 7;
    if (W) {
        f32x4 wv[8];
#pragma unroll
        for (int i = 0; i < 8; ++i) wv[i] = *(const f32x4*)(W + (size_t)(k0 + 8 * i + (lane >> 3)) * N + n0 + (lane & 7) * 4);
#pragma unroll
        for (int i = 0; i < 8; ++i) { const int kk = 8 * i + (lane >> 3); f32x4 v = wv[i]; if (ks) v *= ks[k0 + kk];
            LAS float* d = scr + kk * 33 + (lane & 7) * 4; d[0] = v.x; d[1] = v.y; d[2] = v.z; d[3] = v.w; }
        asm volatile("s_waitcnt lgkmcnt(0)" ::: "memory");
#pragma unroll
        for (int j = 0; j < 4; ++j) { const int n = (lane >> 3) + 8 * j; const LAS float* s = scr + (8 * c) * 33 + n;
            u32x4 o; o.x = cvtpk(s[0 * 33], s[1 * 33]); o.y = cvtpk(s[2 * 33], s[3 * 33]); o.z = cvtpk(s[4 * 33], s[5 * 33]); o.w = cvtpk(s[6 * 33], s[7 * 33]);
            *(u32x4*)(dst + (size_t)(nrow0 + n0 + n) * ldt + kcol0 + k0 + 8 * c) = o; }
        asm volatile("s_waitcnt lgkmcnt(0)" ::: "memory");
    } else {
#pragma unroll
        for (int j = 0; j < 4; ++j) { const int n = (lane >> 3) + 8 * j; *(u32x4*)(dst + (size_t)(nrow0 + n0 + n) * ldt + kcol0 + k0 + 8 * c) = (u32x4){0u, 0u, 0u, 0u}; }
    }
}
struct WaveCtx { int gw, ngw, lane; LAS float* scr; };
DI void tmat(const WaveCtx& w, int& itbase, const float* W, int K, int N, bf16_t* dst, int ldt, int nrow0, int kcol0, const float* ks) {
    const int nblk = N / 32, nit = (K / 64) * nblk;
    int first = (w.gw - itbase % w.ngw + w.ngw) % w.ngw;
    for (int it = first; it < nit; it += w.ngw) titem(W, N, dst, ldt, nrow0, kcol0, ks, it / nblk, it % nblk, w.scr, w.lane);
    itbase += nit;
}
DI void tzero(const WaveCtx& w, int& itbase, int K, int N, bf16_t* dst, int ldt, int nrow0, int kcol0) {
    const int nblk = N / 32, nit = (K / 64) * nblk;
    int first = (w.gw - itbase % w.ngw + w.ngw) % w.ngw;
    for (int it = first; it < nit; it += w.ngw) titem(nullptr, N, dst, ldt, nrow0, kcol0, nullptr, it / nblk, it % nblk, w.scr, w.lane);
    itbase += nit;
}

DI void convert_mixer_weights(KP p, const WaveCtx& w, int layer) {
    const int kind = layer % 3, j = layer / 3; unsigned char* ws = p->ws; int ib = 0;
    if (kind == 0) {
        tmat(w, ib, p->in[13] + (size_t)j * D * 3072, D, 3072, (bf16_t*)(ws + WS_WQKVT), D, 0, 0, nullptr);
        tmat(w, ib, p->in[18] + (size_t)j * D * D, D, D, (bf16_t*)(ws + WS_WOT), D, 0, 0, nullptr);
    } else if (kind == 2) {
        tmat(w, ib, p->in[35], D, 1536, (bf16_t*)(ws + WS_WQKVT), D, 0, 0, nullptr);
        tmat(w, ib, p->in[39], D, D, (bf16_t*)(ws + WS_WOT), D, 0, 0, nullptr);
    } else {
        bf16_t* s1 = (bf16_t*)(ws + WS_S1T); const float* mu = p->in[19];
        for (int m = 0; m < 3; ++m) {
            tmat(w, ib, p->in[20] + (size_t)m * D * D, D, D, s1, 2048, m * 1024, 0, nullptr);
        }
        for (int d = 0; d < 2; ++d) {
            tmat(w, ib, p->in[22] + (size_t)d * D * 64, D, 64, s1, 2048, 3072 + d * 64, 0, nullptr);
            tmat(w, ib, p->in[22] + (size_t)d * D * 64, D, 64, s1, 2048, 3072 + d * 64, 1024, mu + 3 * D);
            tmat(w, ib, p->in[25] + (size_t)d * D * 64, D, 64, s1, 2048, 3200 + d * 64, 0, nullptr);
            tmat(w, ib, p->in[25] + (size_t)d * D * 64, D, 64, s1, 2048, 3200 + d * 64, 1024, mu + 4 * D);
        }
        tmat(w, ib, p->in[27], D, 128, s1, 2048, 3328, 0, nullptr);
        tmat(w, ib, p->in[27], D, 128, s1, 2048, 3328, 1024, mu + 5 * D);
        tzero(w, ib, 2048, 128, s1, 2048, 3456, 0);
        bf16_t* s2 = (bf16_t*)(ws + WS_S2T);
        for (int rg = 0; rg < 4; ++rg)
            for (int kb = 0; kb < 4; ++kb) {
                if (kb == rg) tmat(w, ib, (rg < 2 ? p->in[23] : p->in[26]) + (size_t)(rg & 1) * 64 * D, 64, D, s2, 256, rg * 1024, kb * 64, nullptr);
                else tzero(w, ib, 64, D, s2, 256, rg * 1024, kb * 64);
            }
        bf16_t* g2 = (bf16_t*)(ws + WS_G2T);
        tmat(w, ib, p->in[28], 128, D, g2, 256, 0, 0, nullptr);
        tzero(w, ib, 128, D, g2, 256, 0, 128);
        tmat(w, ib, p->in[34], D, D, (bf16_t*)(ws + WS_RWO), D, 0, 0, nullptr);
    }
}
DI void convert_w1(KP p, const WaveCtx& w, int layer) { int ib = 0; tmat(w, ib, p->in[11] + (size_t)layer * D * FFD, D, FFD, (bf16_t*)(p->ws + ws_w1t(layer)), D, 0, 0, nullptr); }
DI void convert_w2(KP p, const WaveCtx& w, int layer) { int ib = 0; tmat(w, ib, p->in[12] + (size_t)layer * D * FFD, FFD, D, (bf16_t*)(p->ws + ws_w2t(layer)), FFD, 0, 0, nullptr); }

DI void phase_mod(KP p, LAS unsigned char* lds, const int tid) {
    LAS float* sl = (LAS float*)lds;
    LAS float* red = sl + 3 * 1024;
    for (int i = tid; i < 3 * 1024; i += 512) { const int c = i >> 10, k = i & 1023; const float v = (c == 0) ? p->in[8][k] : p->in[7][(c - 1) * 1024 + k]; sl[i] = v / (1.f + __expf(-v)); }
    __syncthreads();
    float* mod = (float*)(p->ws + WS_MOD);
    const int cg_ = tid & 63, kg = tid >> 6;
    for (int unit = blockIdx.x; unit < 4 * 96; unit += gridDim.x) {
        const int l = unit / 96, c0 = (unit % 96) * 64;
        const float* W = p->in[9] + (size_t)l * D * MODW + c0 + cg_;
        float a0 = 0.f, a1 = 0.f, a2 = 0.f;
#pragma unroll 8
        for (int k = kg * 128; k < kg * 128 + 128; ++k) { const float wv = W[(size_t)k * MODW]; a0 += sl[k] * wv; a1 += sl[1024 + k] * wv; a2 += sl[2048 + k] * wv; }
        red[(kg * 3 + 0) * 64 + cg_] = a0; red[(kg * 3 + 1) * 64 + cg_] = a1; red[(kg * 3 + 2) * 64 + cg_] = a2;
        __syncthreads();
        if (tid < 192) { const int c = tid >> 6; float s = p->in[10][l * MODW + c0 + cg_];
#pragma unroll
            for (int q = 0; q < 8; ++q) s += red[(q * 3 + c) * 64 + cg_];
            mod[(size_t)(l * 3 + c) * MODW + c0 + cg_] = s; }
        __syncthreads();
    }
    float* rc = (float*)(p->ws + WS_ROPE); float* rs = rc + 2048 * 32;
    for (int i = blockIdx.x * 512 + tid; i < 2048 * 32; i += gridDim.x * 512) {
        const int t = i >> 5, jj = i & 31; const int pos = (jj < 16) ? (t >> 6) : (t & 63); const int f = jj & 15;
        const float inv = __builtin_amdgcn_exp2f(-(float)f * (13.287712379549449f / 16.f)); const float ang = (float)pos * inv;
        const float kq = rintf(ang * 0.15915494309189535f); float rr = fmaf(-kq, 6.2831855f, ang); rr = fmaf(-kq, -1.7484555e-7f, rr);
        rc[i] = __cosf(rr); rs[i] = __sinf(rr);
    }
}

DI void norm_row(const float* xr, const float* sc, const float* sh, int lane, f32x4 (&h)[4], bool valid) {
    const f32x4* x4 = (const f32x4*)xr + lane; float ss = 0.f;
#pragma unroll
    for (int j = 0; j < 4; ++j) { h[j] = valid ? x4[64 * j] : (f32x4){0.f, 0.f, 0.f, 0.f}; ss += (h[j].x * h[j].x + h[j].y * h[j].y) + (h[j].z * h[j].z + h[j].w * h[j].w); }
    const float rstd = rsqrtf(wave_sum(ss) * (1.f / D) + 1e-6f);
    const f32x4* sc4 = (const f32x4*)sc + lane; const f32x4* sh4 = (const f32x4*)sh + lane;
#pragma unroll
    for (int j = 0; j < 4; ++j) { const f32x4 s = sc4[64 * j], b = sh4[64 * j]; h[j] = valid ? (h[j] * rstd * (1.f + s) + b) : (f32x4){0.f, 0.f, 0.f, 0.f}; }
}
DI const float* xrow_ptr(KP p, int row, bool from_input) {
    if (from_input) return row < M_CTX ? p->in[0] + (size_t)row * D : p->in[1] + (size_t)(row - M_CTX) * D;
    return p->out + O_X + (size_t)row * D;
}
DI void phase_norm(KP p, const WaveCtx& w, int layer, int which) {
    const float* mod = (const float*)(p->ws + WS_MOD) + (size_t)layer * 3 * MODW;
    bf16_t* H = (bf16_t*)(p->ws + WS_A);
    const bool from_in = (layer == 0 && which == 0);
    for (int row = w.gw; row < M_ALL; row += w.ngw) {
        const float* mc = mod + cond_of_row(row) * MODW + which * 3 * D;
        const float* xr = xrow_ptr(p, row, from_in);
        f32x4 h[4];
        if (from_in) { const f32x4* x4 = (const f32x4*)xr + w.lane; f32x4* o4 = (f32x4*)(p->out + O_X + (size_t)row * D) + w.lane;
#pragma unroll
            for (int j = 0; j < 4; ++j) o4[64 * j] = x4[64 * j]; }
        norm_row(xr, mc + D, mc, w.lane, h, true);
        u32x2* o = (u32x2*)(H + (size_t)row * D) + w.lane;
#pragma unroll
        for (int j = 0; j < 4; ++j) { u32x2 v; v.x = cvtpk(h[j].x, h[j].y); v.y = cvtpk(h[j].z, h[j].w); o[64 * j] = v; }
    }
}
DI void phase_norm_rwkv(KP p, const WaveCtx& w, int layer) {
    const float* mod = (const float*)(p->ws + WS_MOD) + (size_t)layer * 3 * MODW;
    bf16_t* A2 = (bf16_t*)(p->ws + WS_A); bf16_t* XS = (bf16_t*)(p->ws + WS_XS);
    for (int row = w.gw; row < M_ALL; row += w.ngw) {
        const float* mc = mod + cond_of_row(row) * MODW;
        int t, T; if (row < M_CTX) { t = row & 255; T = T_CTX; } else { t = (row - M_CTX) & 2047; T = T_LAT; }
        const float* xr = p->out + O_X + (size_t)row * D;
        f32x4 hc[4], hp[4], hn[4];
        norm_row(xr, mc + D, mc, w.lane, hc, true);
        norm_row(xr - D, mc + D, mc, w.lane, hp, t > 0);
        norm_row(t < T - 1 ? xr + D : xr, mc + D, mc, w.lane, hn, t < T - 1);
        u32x2* o = (u32x2*)(A2 + (size_t)row * 2048) + w.lane;
#pragma unroll
        for (int j = 0; j < 4; ++j) {
            u32x2 v; v.x = cvtpk(hc[j].x, hc[j].y); v.y = cvtpk(hc[j].z, hc[j].w); o[64 * j] = v;
            const f32x4 xx = 0.5f * (hp[j] + hn[j]) - hc[j];
            u32x2 q; q.x = cvtpk(xx.x, xx.y); q.y = cvtpk(xx.z, xx.w); o[256 + 64 * j] = q;
#pragma unroll
            for (int m = 0; m < 3; ++m) {
                const f32x4 muv = ((const f32x4*)(p->in[19] + m * D))[w.lane + 64 * j]; const f32x4 xs = hc[j] + xx * muv;
                u32x2 r; r.x = cvtpk(xs.x, xs.y); r.y = cvtpk(xs.z, xs.w);
                ((u32x2*)(XS + ((size_t)m * M_ALL + row) * D))[w.lane + 64 * j] = r;
            }
        }
    }
}

struct AttnCfg {
    int ldq;
    int nq, nk;
    int vw;
    int dv, nvh;
    int kl, j;
    const float *qn, *kn;
    float *kout, *vout;
    const float *ck, *cv;
};
DI AttnCfg make_cfg(KP p, int kind, int j) {
    AttnCfg c;
    if (kind == 0) { c.ldq = 3072; c.nq = 16; c.nk = 16; c.vw = 1024; c.dv = 128; c.nvh = 8; c.kl = 2; c.j = j; c.qn = p->in[14] + j * 64; c.kn = p->in[15] + j * 64;
        c.kout = p->out + O_DAK; c.vout = p->out + O_DAV; c.ck = p->in[2]; c.cv = p->in[3]; }
    else { c.ldq = 1536; c.nq = 16; c.nk = 4; c.vw = 256; c.dv = 64; c.nvh = 4; c.kl = 1; c.j = 0; c.qn = p->in[36]; c.kn = p->in[37];
        c.kout = p->out + O_SWK; c.vout = p->out + O_SWV; c.ck = p->in[5]; c.cv = p->in[6]; }
    return c;
}

DI void phase_qkprep(KP p, const WaveCtx& w, const AttnCfg& c, LAS unsigned char* lds_wave) {
    bf16_t* QKV = (bf16_t*)(p->ws + WS_QKV); bf16_t* Kf = (bf16_t*)(p->ws + WS_KF);
    const float* rc = (const float*)(p->ws + WS_ROPE); const float* rs = rc + 2048 * 32;
    const int lane = w.lane, g = lane >> 1, half = lane & 1;
    const int ng = c.nq + c.nk;
    for (int row = w.gw; row < M_ALL; row += w.ngw) {
        const bool lat = row >= M_CTX; const int tl = lat ? ((row - M_CTX) & 2047) : 0;
        const int b = row >> 8, t = row & 255;
        if (g < ng) {
            const bool isq = g < c.nq;
            const int col = (isq ? g * 64 : 1024 + (g - c.nq) * 64) + half * 32;
            bf16_t* src = QKV + (size_t)row * c.ldq + col;
            float v[32]; float ss = 0.f;
#pragma unroll
            for (int q4 = 0; q4 < 4; ++q4) { const u32x4 wv = *(const u32x4*)(src + 8 * q4); float f[8]; unpack8(wv, f);
#pragma unroll
                for (int e = 0; e < 8; ++e) { v[8 * q4 + e] = f[e]; ss += f[e] * f[e]; } }
            ss = sum2(ss);
            const float rstd = rsqrtf(ss * (1.f / 64.f) + 1e-6f);
            const float* gn = (isq ? c.qn : c.kn) + half * 32;
#pragma unroll
            for (int e = 0; e < 32; ++e) v[e] = v[e] * rstd * gn[e];
            if (lat) {
                const float* cp = rc + tl * 32; const float* sp = rs + tl * 32;
#pragma unroll
                for (int e = 0; e < 32; ++e) { const float pr = dpp_mov<0xB1>(v[e]); const float cs = cp[e], sn = sp[e]; v[e] = half ? (v[e] * cs + pr * sn) : (v[e] * cs - pr * sn); }
            }
            if (!isq && !lat) {
                float* ko = c.kout + ((size_t)(b * c.kl + c.j) * 256 + t) * (c.nk * 64) + (g - c.nq) * 64 + half * 32;
#pragma unroll
                for (int q4 = 0; q4 < 8; ++q4) *(f32x4*)(ko + 4 * q4) = (f32x4){v[4 * q4], v[4 * q4 + 1], v[4 * q4 + 2], v[4 * q4 + 3]};
            }
            if (isq) {
#pragma unroll
                for (int q4 = 0; q4 < 4; ++q4) { float f[8];
#pragma unroll
                    for (int e = 0; e < 8; ++e) f[e] = v[8 * q4 + e] * QSCALE;
                    *(u32x4*)(src + 8 * q4) = pack8(f); }
            } else {
                bf16_t* kd = Kf + ((size_t)(row >> 5) * c.nk + (g - c.nq)) * 2048 + (row & 31) * 8;
#pragma unroll
                for (int q4 = 0; q4 < 4; ++q4) { float f[8];
#pragma unroll
                    for (int e = 0; e < 8; ++e) f[e] = v[8 * q4 + e];
                    *(u32x4*)(kd + (half * 2 + (q4 >> 1)) * 512 + (q4 & 1) * 256) = pack8(f); }
            }
        }
        if (!lat) {
            const bf16_t* vs = QKV + (size_t)row * c.ldq + 1024 + c.nk * 64;
            float* vo = c.vout + ((size_t)(b * c.kl + c.j) * 256 + t) * c.vw;
            for (int i = lane * 4; i < c.vw; i += 256) { const u32x2 wv = *(const u32x2*)(vs + i); *(f32x4*)(vo + i) = (f32x4){bflo(wv.x), bfhi(wv.x), bflo(wv.y), bfhi(wv.y)}; }
        }
    }
    {
        const int kw = c.nk * 64; bf16_t* Kc = (bf16_t*)(p->ws + WS_KC);
        const int n8 = 2 * 256 * kw / 8;
        for (int i = w.gw * 64 + lane; i < n8; i += w.ngw * 64) {
            const int r = (i * 8) / kw, cc = (i * 8) % kw; const int b = r >> 8, t = r & 255;
            const float* s = c.ck + ((size_t)(b * c.kl + c.j) * 256 + t) * kw + cc;
            const f32x4 a = *(const f32x4*)s, bq = *(const f32x4*)(s + 4);
            u32x4 o; o.x = cvtpk(a.x, a.y); o.y = cvtpk(a.z, a.w); o.z = cvtpk(bq.x, bq.y); o.w = cvtpk(bq.z, bq.w);
            const int gk = cc >> 6, cl = cc & 63;
            *(u32x4*)(Kc + ((size_t)(r >> 5) * c.nk + gk) * 2048 + (cl >> 4) * 512 + ((cl >> 3) & 1) * 256 + (r & 31) * 8) = o;
        }
    }
    {
        LAS bf16_t* T = (LAS bf16_t*)lds_wave; const int pitch = c.dv + 2;
        bf16_t* VtC = (bf16_t*)(p->ws + WS_VTC); bf16_t* VtL = (bf16_t*)(p->ws + WS_VTL);
        const int n_ctx = 32 * 8 * c.nvh, n_lat = 2 * 64 * c.nvh, n_cache = 2 * 8 * c.nvh, ntile = n_ctx + n_lat + n_cache;
        const int cpr = c.dv / 8;
        for (int tile = w.gw; tile < ntile; tile += w.ngw) {
            int vh, blk, seq, kindt; int r = tile;
            if (r < n_ctx) { kindt = 0; vh = r % c.nvh; r /= c.nvh; blk = r % 8; seq = r / 8; }
            else if (r < n_ctx + n_lat) { r -= n_ctx; kindt = 1; vh = r % c.nvh; r /= c.nvh; blk = r % 64; seq = r / 64; }
            else { r -= n_ctx + n_lat; kindt = 2; vh = r % c.nvh; r /= c.nvh; blk = r % 8; seq = r / 8; }
            for (int ch = lane; ch < 32 * cpr; ch += 64) {
                const int tr = ch / cpr, cc = (ch % cpr) * 8; u32x4 wv;
                if (kindt == 2) { const float* s = c.cv + ((size_t)(seq * c.kl + c.j) * 256 + blk * 32 + tr) * c.vw + vh * c.dv + cc;
                    const f32x4 a = *(const f32x4*)s, bq = *(const f32x4*)(s + 4); wv.x = cvtpk(a.x, a.y); wv.y = cvtpk(a.z, a.w); wv.z = cvtpk(bq.x, bq.y); wv.w = cvtpk(bq.z, bq.w); }
                else { const int row = (kindt == 0 ? seq * 256 : M_CTX + seq * 2048) + blk * 32 + tr;
                    wv = *(const u32x4*)(QKV + (size_t)row * c.ldq + 1024 + c.nk * 64 + vh * c.dv + cc); }
                LAS unsigned* d = (LAS unsigned*)(T + tr * pitch + cc);
                d[0] = wv.x; d[1] = wv.y; d[2] = wv.z; d[3] = wv.w;
            }
            asm volatile("s_waitcnt lgkmcnt(0)" ::: "memory");
            bf16_t* dst;
            if (kindt == 0) dst = VtC + (size_t)((seq * c.nvh + vh) * c.dv) * 256 + (size_t)blk * 32 * c.dv;
            else dst = VtL + (size_t)((seq * c.nvh + vh) * c.dv) * 2304 + (size_t)((kindt == 1 ? 8 : 0) + blk) * 32 * c.dv;
            for (int id = lane; id < c.dv * 4; id += 64) {
                const int r = id & 31, hi = (id >> 5) & 1, sl = (id >> 6) & 1, d = (id >> 7) * 32 + r;
                unsigned short e[8];
#pragma unroll
                for (int q = 0; q < 8; ++q) { const int kv = 16 * sl + 8 * (q >> 2) + 4 * hi + (q & 3); e[q] = T[kv * pitch + d]; }
                u32x4 o; o.x = e[0] | ((unsigned)e[1] << 16); o.y = e[2] | ((unsigned)e[3] << 16); o.z = e[4] | ((unsigned)e[5] << 16); o.w = e[6] | ((unsigned)e[7] << 16);
                *(u32x4*)(dst + (size_t)id * 8) = o;
            }
            asm volatile("s_waitcnt lgkmcnt(0)" ::: "memory");
        }
    }
}

#define MFMA32(a, b, c) __builtin_amdgcn_mfma_f32_32x32x16_bf16((a), (b), (c), 0, 0, 0)
DI int crow(int r, int hi) { return (r & 3) + 8 * (r >> 2) + 4 * hi; }

template <int NDT, bool MASK>
DI void attn_seg(f32x16 (&o)[NDT], float& m, float& l, const bf16x8 (&qr)[4], const bf16_t* K, int kts, const bf16_t* Vt, int ntiles, int lane, int hi, int qpos, int kpos0) {
    const bf16_t* kp = K + lane * 8;
    const bf16_t* vp = Vt + lane * 8;
    bf16x8 kf[4];
#pragma unroll
    for (int d0 = 0; d0 < 4; ++d0) kf[d0] = *(const bf16x8*)(kp + 512 * d0);
    for (int t = 0; t < ntiles; ++t) {
        bf16x8 vf[NDT][2];
#pragma unroll
        for (int dt = 0; dt < NDT; ++dt) { vf[dt][0] = *(const bf16x8*)(vp + (size_t)(t * NDT + dt) * 1024); vf[dt][1] = *(const bf16x8*)(vp + (size_t)(t * NDT + dt) * 1024 + 512); }
        f32x16 pr;
#pragma unroll
        for (int r = 0; r < 16; ++r) pr[r] = 0.f;
#pragma unroll
        for (int d0 = 0; d0 < 4; ++d0) pr = MFMA32(kf[d0], qr[d0], pr);
        if (t + 1 < ntiles) {
            const bf16_t* kn = kp + (size_t)(t + 1) * kts;
#pragma unroll
            for (int d0 = 0; d0 < 4; ++d0) kf[d0] = *(const bf16x8*)(kn + 512 * d0);
        }
        if (MASK) {
#pragma unroll
            for (int r = 0; r < 16; ++r) { const int dl = kpos0 + t * 32 + crow(r, hi) - qpos; if (dl > 128 || dl < -128) pr[r] = -1e30f; }
        }
        float mx = fmaxf(fmaxf(pr[0], pr[1]), fmaxf(pr[2], pr[3]));
#pragma unroll
        for (int r = 4; r < 16; r += 4) mx = fmaxf(mx, fmaxf(fmaxf(pr[r], pr[r + 1]), fmaxf(pr[r + 2], pr[r + 3])));
        mx = fmaxf(mx, __shfl_xor(mx, 32));
        if (__builtin_amdgcn_ballot_w64(mx > m) != 0ull) {
            const float mn = fmaxf(m, mx);
            const float alpha = __builtin_amdgcn_exp2f(m - mn);
            m = mn; l *= alpha;
#pragma unroll
            for (int dt = 0; dt < NDT; ++dt)
#pragma unroll
                for (int r = 0; r < 16; ++r) o[dt][r] *= alpha;
        }
        float rsum = 0.f;
#pragma unroll
        for (int r = 0; r < 16; ++r) { pr[r] = __builtin_amdgcn_exp2f(pr[r] - m); rsum += pr[r]; }
        l += rsum;
        bf16x8 pb[2];
#pragma unroll
        for (int s = 0; s < 2; ++s) { u32x4 wv; wv.x = cvtpk(pr[8 * s], pr[8 * s + 1]); wv.y = cvtpk(pr[8 * s + 2], pr[8 * s + 3]); wv.z = cvtpk(pr[8 * s + 4], pr[8 * s + 5]); wv.w = cvtpk(pr[8 * s + 6], pr[8 * s + 7]); pb[s] = __builtin_bit_cast(bf16x8, wv); }
#pragma unroll
        for (int dt = 0; dt < NDT; ++dt) {
            o[dt] = MFMA32(vf[dt][0], pb[0], o[dt]); o[dt] = MFMA32(vf[dt][1], pb[1], o[dt]);
        }
    }
}
DI void load_q(bf16x8 (&qr)[4], const bf16_t* Q, int ldq, int r32, int hi) {
#pragma unroll
    for (int d0 = 0; d0 < 4; ++d0) qr[d0] = *(const bf16x8*)(Q + (size_t)r32 * ldq + 16 * d0 + 8 * hi);
}
template <int NDT> DI void zero_o(f32x16 (&o)[NDT]) {
#pragma unroll
    for (int dt = 0; dt < NDT; ++dt)
#pragma unroll
        for (int r = 0; r < 16; ++r) o[dt][r] = 0.f;
}

DI void da_unit(KP p, int layer, bool is_lat, int b, int h, int qb, int lane, float lam, float lam_init, LAS float* osm, int mpsel) {
    const int j = layer / 3;
    const bf16_t* QKV = (const bf16_t*)(p->ws + WS_QKV); const bf16_t* Kc = (const bf16_t*)(p->ws + WS_KC); const bf16_t* Kf = (const bf16_t*)(p->ws + WS_KF);
    const bf16_t* VtC = (const bf16_t*)(p->ws + WS_VTC); const bf16_t* VtL = (const bf16_t*)(p->ws + WS_VTL);
    bf16_t* AO = (bf16_t*)(p->ws + WS_AO);
    const int row0 = (is_lat ? M_CTX + b * 2048 : b * 256) + qb * 32;
    const int seq0 = is_lat ? M_CTX + b * 2048 : b * 256;
    f32x16 o2[4];
    const int mp_lo = mpsel < 0 ? 0 : mpsel, mp_hi = mpsel < 0 ? 2 : mpsel + 1;
#pragma unroll 1
    for (int mp = mp_lo; mp < mp_hi; ++mp) {
        int r32 = lane & 31, hi = lane >> 5; asm volatile("" : "+v"(r32), "+v"(hi));
        bf16x8 qr[4]; load_q(qr, QKV + (size_t)row0 * 3072 + h * 128 + mp * 64, 3072, r32, hi);
        float m = -1e30f, l = 0.f; zero_o<4>(o2);
        const int gsel = h * 2 + mp;
        if (is_lat) {
            const bf16_t* vt = VtL + (size_t)((b * 8 + h) * 128) * 2304;
            attn_seg<4, false>(o2, m, l, qr, Kc + ((size_t)(b * 8) * 16 + gsel) * 2048, 16 * 2048, vt, 8, lane, hi, 0, 0);
            attn_seg<4, false>(o2, m, l, qr, Kf + ((size_t)(seq0 >> 5) * 16 + gsel) * 2048, 16 * 2048, vt + 8 * 4096, 64, lane, hi, 0, 0);
        } else {
            attn_seg<4, false>(o2, m, l, qr, Kf + ((size_t)(seq0 >> 5) * 16 + gsel) * 2048, 16 * 2048, VtC + (size_t)((b * 8 + h) * 128) * 256, 8, lane, hi, 0, 0);
        }
        l += __shfl_xor(l, 32);
        const float il = 1.f / l;
        if (mpsel < 0) {
            if (mp == 0) {
#pragma unroll
                for (int dt = 0; dt < 4; ++dt)
#pragma unroll
                    for (int r = 0; r < 16; ++r) osm[(dt * 16 + r) * 64 + lane] = o2[dt][r] * il;
            } else {
#pragma unroll
                for (int dt = 0; dt < 4; ++dt)
#pragma unroll
                    for (int r = 0; r < 16; ++r) o2[dt][r] = osm[(dt * 16 + r) * 64 + lane] - lam * o2[dt][r] * il;
            }
        } else {
#pragma unroll
            for (int dt = 0; dt < 4; ++dt)
#pragma unroll
                for (int r = 0; r < 16; ++r) o2[dt][r] *= il;
        }
    }
    if (mpsel == 1) {
#pragma unroll
        for (int dt = 0; dt < 4; ++dt)
#pragma unroll
            for (int r = 0; r < 16; ++r) osm[(dt * 16 + r) * 64 + lane] = o2[dt][r];
    }
    if (mpsel >= 0) {
        asm volatile("s_waitcnt lgkmcnt(0)\n\ts_barrier" ::: "memory");
        if (mpsel == 1) return;
#pragma unroll
        for (int dt = 0; dt < 4; ++dt)
#pragma unroll
            for (int r = 0; r < 16; ++r) o2[dt][r] -= lam * osm[(dt * 16 + r) * 64 + lane];
    }
    f32x16 (&o1)[4] = o2;
    int r32 = lane & 31, hi = lane >> 5; asm volatile("" : "+v"(r32), "+v"(hi));
    float ss = 0.f;
#pragma unroll
    for (int dt = 0; dt < 4; ++dt)
#pragma unroll
        for (int r = 0; r < 16; ++r) ss += o1[dt][r] * o1[dt][r];
    ss += __shfl_xor(ss, 32);
    const float sc = rsqrtf(ss * (1.f / 128.f) + 1e-6f) * (1.f - lam_init);
    const float* sg = p->in[17] + j * 128;
    bf16_t* orow = AO + (size_t)(row0 + r32) * D + h * 128;
#pragma unroll
    for (int dt = 0; dt < 4; ++dt)
#pragma unroll
        for (int k4 = 0; k4 < 4; ++k4) {
            const int d = dt * 32 + 8 * k4 + 4 * hi; const f32x4 gq = *(const f32x4*)(sg + d);
            u32x2 wv; wv.x = cvtpk(o1[dt][4 * k4] * sc * gq.x, o1[dt][4 * k4 + 1] * sc * gq.y); wv.y = cvtpk(o1[dt][4 * k4 + 2] * sc * gq.z, o1[dt][4 * k4 + 3] * sc * gq.w);
            *(u32x2*)(orow + d) = wv;
        }
}
DI void phase_attn_da(KP p, int layer, int wave, int lane, LAS float* osm) {
    const int j = layer / 3;
    const float* lp = p->in[16] + j * 256;
    const float s1 = wave_sum(lp[lane] * lp[64 + lane]), s2 = wave_sum(lp[128 + lane] * lp[192 + lane]);
    const float lam_init = 0.8f - 0.6f * expf(-0.3f * (float)layer);
    const float lam = expf(s1) - expf(s2) + lam_init;
    const int G = gridDim.x;
    if (G == 256) {
        const int x = blockIdx.x & 7, slot = blockIdx.x >> 3;
        {
            const int idx = slot * 4 + (wave & 3); const int bh = 2 * x + (idx >> 6), qb = idx & 63;
            da_unit(p, layer, true, bh >> 3, bh & 7, qb, lane, lam, lam_init, osm - (wave >> 2) * 4 * 4096, wave >> 2);
        }
        { const int bh = x * 32 + slot; da_unit(p, layer, false, bh >> 3, bh & 7, wave, lane, lam, lam_init, osm, -1); }
    } else {
        if (wave < 4) { for (int u = blockIdx.x * 4 + wave; u < 1024; u += G * 4) { const int qb = u & 63, bh = u >> 6; da_unit(p, layer, true, bh >> 3, bh & 7, qb, lane, lam, lam_init, osm, -1); } }
        else { for (int u = blockIdx.x * 4 + (wave - 4); u < 2048; u += G * 4) { const int bh = u >> 3, qb = u & 7; da_unit(p, layer, false, bh >> 3, bh & 7, qb, lane, lam, lam_init, osm, -1); } }
    }
}

DI void swa_unit(KP p, bool is_lat, int b, int qh, int qb, int lane) {
    const bf16_t* QKV = (const bf16_t*)(p->ws + WS_QKV); const bf16_t* Kc = (const bf16_t*)(p->ws + WS_KC); const bf16_t* Kf = (const bf16_t*)(p->ws + WS_KF);
    const bf16_t* VtC = (const bf16_t*)(p->ws + WS_VTC); const bf16_t* VtL = (const bf16_t*)(p->ws + WS_VTL);
    bf16_t* AO = (bf16_t*)(p->ws + WS_AO);
    int r32 = lane & 31, hi = lane >> 5; asm volatile("" : "+v"(r32), "+v"(hi));
    const int kvh = qh >> 2;
    const int seq0 = is_lat ? M_CTX + b * 2048 : b * 256;
    const int row0 = seq0 + qb * 32;
    bf16x8 qr[4]; load_q(qr, QKV + (size_t)row0 * 1536 + qh * 64, 1536, r32, hi);
    f32x16 o[2]; zero_o<2>(o); float m = -1e30f, l = 0.f;
    if (is_lat) {
        const bf16_t* vt = VtL + (size_t)((b * 4 + kvh) * 64) * 2304;
        attn_seg<2, false>(o, m, l, qr, Kc + ((size_t)(b * 8) * 4 + kvh) * 2048, 4 * 2048, vt, 8, lane, hi, 0, 0);
        const int q0 = qb * 32; int t0 = q0 - 128; if (t0 < 0) t0 = 0; int t1 = q0 + 160; if (t1 > 2048) t1 = 2048;
        attn_seg<2, true>(o, m, l, qr, Kf + ((size_t)((seq0 + t0) >> 5) * 4 + kvh) * 2048, 4 * 2048, vt + (size_t)(8 + (t0 >> 5)) * 2048, (t1 - t0) >> 5, lane, hi, q0 + r32, t0);
    } else {
        attn_seg<2, false>(o, m, l, qr, Kf + ((size_t)(seq0 >> 5) * 4 + kvh) * 2048, 4 * 2048, VtC + (size_t)((b * 4 + kvh) * 64) * 256, 8, lane, hi, 0, 0);
    }
    l += __shfl_xor(l, 32);
    l += __builtin_amdgcn_exp2f(p->in[38][qh] * LOG2E - m);
    const float il = 1.f / l;
    bf16_t* orow = AO + (size_t)(row0 + r32) * D + qh * 64;
#pragma unroll
    for (int dt = 0; dt < 2; ++dt)
#pragma unroll
        for (int k4 = 0; k4 < 4; ++k4) {
            const int d = dt * 32 + 8 * k4 + 4 * hi;
            u32x2 wv; wv.x = cvtpk(o[dt][4 * k4] * il, o[dt][4 * k4 + 1] * il); wv.y = cvtpk(o[dt][4 * k4 + 2] * il, o[dt][4 * k4 + 3] * il);
            *(u32x2*)(orow + d) = wv;
        }
}
DI void phase_attn_swa(KP p, int wave, int lane) {
    const int G = gridDim.x;
    if (G == 256) {
        const int x = blockIdx.x & 7, slot = blockIdx.x >> 3;
        { const int idx = slot * 8 + wave; const int qh = (x & 3) * 4 + (idx >> 6), qb = idx & 63; swa_unit(p, true, x >> 2, qh, qb, lane); }
        for (int it = 0; it < 2; ++it) { const int pair = x * 64 + slot * 2 + it; swa_unit(p, false, pair >> 4, pair & 15, wave, lane); }
    } else {
        for (int u = blockIdx.x * 8 + wave; u < 2048; u += G * 8) { const int qb = u & 63, bq = u >> 6; swa_unit(p, true, bq >> 4, bq & 15, qb, lane); }
        for (int u = blockIdx.x * 8 + wave; u < 4096; u += G * 8) { const int qb = u & 7, bq = u >> 3; swa_unit(p, false, bq >> 4, bq & 15, qb, lane); }
    }
}

struct ScanRun {
    int row0;
    int h, dir;
    int t_first;
    int nsteps;
    int kind;
    const float* init;
    int init_ident;
    bf16_t* yout;
    float* fin;
};
template <int NR, bool HASV, bool HASY>
DI void scan_run(KP p, const ScanRun& R, LAS float* sm, int lane, int rowbase) {
    const bf16_t* RKV = (const bf16_t*)(p->ws + WS_B);
    const bf16_t* E = (const bf16_t*)(p->ws + WS_E) + (size_t)R.dir * M_ALL * D;
    const bf16_t* AA = (const bf16_t*)(p->ws + WS_AA) + (size_t)R.dir * M_ALL * D;
    const int rg = lane >> 3, ks = lane & 7;
    const int st = lane >> 3, cs = lane & 7;
    const int hc = R.h * 64 + cs * 8;
    const int row_l = rowbase + NR * rg;
    float kkw[8], kaw[8];
#pragma unroll
    for (int e = 0; e < 8; ++e) { kkw[e] = p->in[29][hc + e]; kaw[e] = p->in[30][hc + e]; }
    f32x2 s[NR][4];
#pragma unroll
    for (int i = 0; i < NR; ++i)
#pragma unroll
        for (int q = 0; q < 4; ++q) {
            f32x2 v = {0.f, 0.f};
            if (R.init) v = *(const f32x2*)(R.init + (row_l + i) * 64 + 8 * ks + 2 * q);
            else if (R.init_ident) { v.x = (row_l + i == 8 * ks + 2 * q) ? 1.f : 0.f; v.y = (row_l + i == 8 * ks + 2 * q + 1) ? 1.f : 0.f; }
            s[i][q] = v;
        }
    const int sgn = R.dir ? -1 : 1;
    const int nch = R.nsteps >> 3;
    u32x4 gr, gk, gv, ge, ga;
    auto issue = [&](int c) {
        const int t = R.t_first + sgn * (c * 8 + st);
        const size_t row = (size_t)(R.row0 + t);
        gr = *(const u32x4*)(RKV + row * 3072 + hc); gk = *(const u32x4*)(RKV + row * 3072 + 1024 + hc); if (HASV) gv = *(const u32x4*)(RKV + row * 3072 + 2048 + hc);
        ge = *(const u32x4*)(E + row * D + hc); ga = *(const u32x4*)(AA + row * D + hc);
    };
    issue(0);
    for (int c = 0; c < nch; ++c) {
        {
            float fr[8], fk[8], fv[8], fe[8], fa[8];
            unpack8(gr, fr); unpack8(gk, fk); if (HASV) unpack8(gv, fv); unpack8(ge, fe); unpack8(ga, fa);
            float ss = 0.f; float kk[8];
#pragma unroll
            for (int e = 0; e < 8; ++e) { kk[e] = fk[e] * kkw[e]; ss += kk[e] * kk[e]; }
            ss = sum8(ss);
            const float rn = rsqrtf(fmaxf(ss, 1e-24f));
            LAS float* d = sm + st * 384 + cs * 8;
            f32x4 o0, o1;
#pragma unroll
            for (int e = 0; e < 8; ++e) kk[e] *= rn;
            o0 = (f32x4){-kk[0], -kk[1], -kk[2], -kk[3]}; o1 = (f32x4){-kk[4], -kk[5], -kk[6], -kk[7]}; *(LAS f32x4*)(d) = o0; *(LAS f32x4*)(d + 4) = o1;
            float wv[8];
#pragma unroll
            for (int e = 0; e < 8; ++e) wv[e] = __expf(-fe[e]);
            o0 = (f32x4){wv[0], wv[1], wv[2], wv[3]}; o1 = (f32x4){wv[4], wv[5], wv[6], wv[7]}; *(LAS f32x4*)(d + 64) = o0; *(LAS f32x4*)(d + 68) = o1;
            o0 = (f32x4){kk[0] * fa[0], kk[1] * fa[1], kk[2] * fa[2], kk[3] * fa[3]}; o1 = (f32x4){kk[4] * fa[4], kk[5] * fa[5], kk[6] * fa[6], kk[7] * fa[7]}; *(LAS f32x4*)(d + 128) = o0; *(LAS f32x4*)(d + 132) = o1;
            if (HASV) {
                float kd[8];
#pragma unroll
                for (int e = 0; e < 8; ++e) kd[e] = fk[e] * (1.f + (fa[e] - 1.f) * kaw[e]);
                o0 = (f32x4){kd[0], kd[1], kd[2], kd[3]}; o1 = (f32x4){kd[4], kd[5], kd[6], kd[7]}; *(LAS f32x4*)(d + 192) = o0; *(LAS f32x4*)(d + 196) = o1;
                o0 = (f32x4){fv[0], fv[1], fv[2], fv[3]}; o1 = (f32x4){fv[4], fv[5], fv[6], fv[7]}; *(LAS f32x4*)(d + 320) = o0; *(LAS f32x4*)(d + 324) = o1;
            }
            if (HASY) { o0 = (f32x4){fr[0], fr[1], fr[2], fr[3]}; o1 = (f32x4){fr[4], fr[5], fr[6], fr[7]}; *(LAS f32x4*)(d + 256) = o0; *(LAS f32x4*)(d + 260) = o1; }
        }
        if (c + 1 < nch) issue(c + 1);
        asm volatile("s_waitcnt lgkmcnt(0)" ::: "memory");
#pragma unroll 2
        for (int q8 = 0; q8 < 8; ++q8) {
            const LAS float* b = sm + q8 * 384;
            f32x2 A[4], W[4], Bv[4], KD[4], Rr[4]; float V[NR];
            { const f32x4 x0 = *(const LAS f32x4*)(b + 8 * ks), x1 = *(const LAS f32x4*)(b + 8 * ks + 4); A[0] = (f32x2){x0.x, x0.y}; A[1] = (f32x2){x0.z, x0.w}; A[2] = (f32x2){x1.x, x1.y}; A[3] = (f32x2){x1.z, x1.w}; }
            { const f32x4 x0 = *(const LAS f32x4*)(b + 64 + 8 * ks), x1 = *(const LAS f32x4*)(b + 64 + 8 * ks + 4); W[0] = (f32x2){x0.x, x0.y}; W[1] = (f32x2){x0.z, x0.w}; W[2] = (f32x2){x1.x, x1.y}; W[3] = (f32x2){x1.z, x1.w}; }
            { const f32x4 x0 = *(const LAS f32x4*)(b + 128 + 8 * ks), x1 = *(const LAS f32x4*)(b + 128 + 8 * ks + 4); Bv[0] = (f32x2){x0.x, x0.y}; Bv[1] = (f32x2){x0.z, x0.w}; Bv[2] = (f32x2){x1.x, x1.y}; Bv[3] = (f32x2){x1.z, x1.w}; }
            if (HASV) {
                { const f32x4 x0 = *(const LAS f32x4*)(b + 192 + 8 * ks), x1 = *(const LAS f32x4*)(b + 192 + 8 * ks + 4); KD[0] = (f32x2){x0.x, x0.y}; KD[1] = (f32x2){x0.z, x0.w}; KD[2] = (f32x2){x1.x, x1.y}; KD[3] = (f32x2){x1.z, x1.w}; }
                { const f32x4 x0 = *(const LAS f32x4*)(b + 320 + row_l); V[0] = x0.x; V[1] = x0.y; V[2] = x0.z; V[3] = x0.w;
                  if (NR == 8) { const f32x4 x1 = *(const LAS f32x4*)(b + 320 + row_l + 4); V[NR - 4] = x1.x; V[NR - 3] = x1.y; V[NR - 2] = x1.z; V[NR - 1] = x1.w; } }
            }
            if (HASY) { const f32x4 x0 = *(const LAS f32x4*)(b + 256 + 8 * ks), x1 = *(const LAS f32x4*)(b + 256 + 8 * ks + 4); Rr[0] = (f32x2){x0.x, x0.y}; Rr[1] = (f32x2){x0.z, x0.w}; Rr[2] = (f32x2){x1.x, x1.y}; Rr[3] = (f32x2){x1.z, x1.w}; }
            float sa[NR];
#pragma unroll
            for (int i = 0; i < NR; ++i) { f32x2 a2 = s[i][0] * A[0]; a2 += s[i][1] * A[1]; a2 += s[i][2] * A[2]; a2 += s[i][3] * A[3]; sa[i] = a2.x + a2.y; }
#pragma unroll
            for (int i = 0; i < NR; ++i) sa[i] += dpp_mov<0xB1>(sa[i]);
#pragma unroll
            for (int i = 0; i < NR; ++i) sa[i] += dpp_mov<0x4E>(sa[i]);
#pragma unroll
            for (int i = 0; i < NR; ++i) sa[i] += dpp_mov<0x141>(sa[i]);
            float y[NR];
#pragma unroll
            for (int i = 0; i < NR; ++i) {
                const f32x2 sa2 = {sa[i], sa[i]};
                f32x2 y2 = {0.f, 0.f};
#pragma unroll
                for (int q = 0; q < 4; ++q) { f32x2 tq = s[i][q] * W[q]; tq += sa2 * Bv[q]; if (HASV) { const f32x2 v2 = {V[i], V[i]}; tq += v2 * KD[q]; } s[i][q] = tq; if (HASY) y2 += tq * Rr[q]; }
                y[i] = y2.x + y2.y;
            }
            if (HASY) {
#pragma unroll
                for (int i = 0; i < NR; ++i) y[i] += dpp_mov<0xB1>(y[i]);
#pragma unroll
                for (int i = 0; i < NR; ++i) y[i] += dpp_mov<0x4E>(y[i]);
#pragma unroll
                for (int i = 0; i < NR; ++i) y[i] += dpp_mov<0x141>(y[i]);
                if (ks == 0) {
                    const int t = R.t_first + sgn * (c * 8 + q8);
                    bf16_t* yp = R.yout + (size_t)(R.row0 + t) * D + R.h * 64 + row_l;
                    if (NR == 8) { float y8[8];
#pragma unroll
                        for (int i = 0; i < 8; ++i) y8[i] = y[i < NR ? i : 0];
                        *(u32x4*)yp = pack8(y8); }
                    else { u32x2 wv; wv.x = cvtpk(y[0], y[1]); wv.y = cvtpk(y[2], y[3]); *(u32x2*)yp = wv; }
                }
            }
        }
        asm volatile("s_waitcnt lgkmcnt(0)" ::: "memory");
    }
    if (R.fin) {
#pragma unroll
        for (int i = 0; i < NR; ++i) {
            float* fp = R.fin + (row_l + i) * 64 + 8 * ks;
            *(f32x4*)(fp) = (f32x4){s[i][0].x, s[i][0].y, s[i][1].x, s[i][1].y}; *(f32x4*)(fp + 4) = (f32x4){s[i][2].x, s[i][2].y, s[i][3].x, s[i][3].y};
        }
    }
}
constexpr int LSEG = 128, NSEG = 16;
DI void lat_scan_ids(int scan, int& b, int& h, int& dir) { b = scan >> 5; h = (scan >> 1) & 15; dir = scan & 1; }
DI void phase_scan1(KP p, LAS float* sm, int wave, int lane) {
    bf16_t* Y = (bf16_t*)(p->ws + WS_Y); float* SEGF = (float*)(p->ws + WS_SEGF);
    for (int blk = blockIdx.x; blk < 256; blk += gridDim.x) {
        if (wave < 4) {
            const int slot = blk * 4 + wave; const int b = slot >> 5, h = (slot >> 1) & 15, dir = slot & 1;
            ScanRun R; R.row0 = b * 256; R.h = h; R.dir = dir; R.t_first = dir ? 255 : 0; R.nsteps = 256; R.kind = 0; R.init = nullptr; R.init_ident = 0;
            R.yout = Y + (size_t)dir * M_ALL * D; R.fin = p->out + O_RW + (size_t)((b * 2 + dir) * 16 + h) * 4096;
            scan_run<8, true, true>(p, R, sm, lane, 0);
        } else {
            for (int sub = 0; sub < 2; ++sub) {
                const int q = (blk * 4 + (wave - 4)) * 2 + sub; if (q >= 1984) break;
                int scan, seg, kind;
                if (q < 1024) { scan = q >> 4; seg = q & 15; kind = 0; } else { const int q2 = q - 1024; scan = q2 / 15; seg = 1 + q2 % 15; kind = 1; }
                int b, h, dir; lat_scan_ids(scan, b, h, dir);
                ScanRun R; R.row0 = M_CTX + b * 2048; R.h = h; R.dir = dir; R.t_first = dir ? (2047 - LSEG * seg) : LSEG * seg; R.nsteps = LSEG; R.kind = kind;
                R.init = (kind == 0 && seg == 0) ? p->in[4] + (size_t)((b * 2 + dir) * 16 + h) * 4096 : nullptr; R.init_ident = kind;
                R.yout = (kind == 0 && seg == 0) ? Y + (size_t)dir * M_ALL * D : nullptr;
                R.fin = SEGF + ((size_t)(scan * NSEG + seg) * 2 + kind) * 4096;
                if (kind == 1) scan_run<8, false, false>(p, R, sm, lane, 0);
                else if (seg == 0) scan_run<8, true, true>(p, R, sm, lane, 0);
                else scan_run<8, true, false>(p, R, sm, lane, 0);
            }
        }
    }
}
DI void phase_combine(KP p, LAS float* sm, const int tid) {
    const float* SEGF = (const float*)(p->ws + WS_SEGF); float* TS = (float*)(p->ws + WS_TS);
    LAS float* smT = sm; LAS float* smP = sm + 4096;
    for (int scan = blockIdx.x; scan < 64; scan += gridDim.x) {
        const int i = tid >> 3, c0 = (tid & 7) * 8;
        float cur[8];
        { const float* L0 = SEGF + ((size_t)(scan * NSEG + 0) * 2 + 0) * 4096 + tid * 8;
#pragma unroll
          for (int e = 0; e < 8; ++e) cur[e] = L0[e]; }
        f32x4 pn0, pn1, ln0, ln1;
        { const float* Pk = SEGF + ((size_t)(scan * NSEG + 1) * 2 + 1) * 4096 + tid * 8; pn0 = *(const f32x4*)Pk; pn1 = *(const f32x4*)(Pk + 4);
          const float* Lk = SEGF + ((size_t)(scan * NSEG + 1) * 2 + 0) * 4096 + tid * 8; ln0 = *(const f32x4*)Lk; ln1 = *(const f32x4*)(Lk + 4); }
        for (int k = 1; k < NSEG; ++k) {
            float* Tk = TS + (size_t)(scan * NSEG + k) * 4096 + tid * 8;
            *(f32x4*)Tk = (f32x4){cur[0], cur[1], cur[2], cur[3]}; *(f32x4*)(Tk + 4) = (f32x4){cur[4], cur[5], cur[6], cur[7]};
            if (k == NSEG - 1) break;
            *(LAS f32x4*)(smT + tid * 8) = (f32x4){cur[0], cur[1], cur[2], cur[3]}; *(LAS f32x4*)(smT + tid * 8 + 4) = (f32x4){cur[4], cur[5], cur[6], cur[7]};
            *(LAS f32x4*)(smP + tid * 8) = pn0; *(LAS f32x4*)(smP + tid * 8 + 4) = pn1;
            float acc[8] = {ln0.x, ln0.y, ln0.z, ln0.w, ln1.x, ln1.y, ln1.z, ln1.w};
            if (k + 1 < NSEG - 1) {
                const float* Pk = SEGF + ((size_t)(scan * NSEG + k + 1) * 2 + 1) * 4096 + tid * 8; pn0 = *(const f32x4*)Pk; pn1 = *(const f32x4*)(Pk + 4);
                const float* Lk = SEGF + ((size_t)(scan * NSEG + k + 1) * 2 + 0) * 4096 + tid * 8; ln0 = *(const f32x4*)Lk; ln1 = *(const f32x4*)(Lk + 4);
            }
            asm volatile("s_waitcnt lgkmcnt(0)\n\ts_barrier" ::: "memory");
#pragma unroll 8
            for (int j = 0; j < 64; ++j) { const float tv = smT[i * 64 + j]; const f32x4 p0 = *(const LAS f32x4*)(smP + j * 64 + c0), p1 = *(const LAS f32x4*)(smP + j * 64 + c0 + 4);
                acc[0] += tv * p0.x; acc[1] += tv * p0.y; acc[2] += tv * p0.z; acc[3] += tv * p0.w; acc[4] += tv * p1.x; acc[5] += tv * p1.y; acc[6] += tv * p1.z; acc[7] += tv * p1.w; }
#pragma unroll
            for (int e = 0; e < 8; ++e) cur[e] = acc[e];
            asm volatile("s_waitcnt lgkmcnt(0)\n\ts_barrier" ::: "memory");
        }
        asm volatile("s_waitcnt lgkmcnt(0)\n\ts_barrier" ::: "memory");
    }
}
DI void phase_scan2(KP p, LAS float* sm, int wave, int lane) {
    bf16_t* Y = (bf16_t*)(p->ws + WS_Y); const float* TS = (const float*)(p->ws + WS_TS);
    for (int u = blockIdx.x * 8 + wave; u < 1920; u += gridDim.x * 8) {
        const int q2 = u >> 1, half = u & 1;
        const int scan = q2 / 15, seg = 1 + q2 % 15; int b, h, dir; lat_scan_ids(scan, b, h, dir);
        ScanRun R; R.row0 = M_CTX + b * 2048; R.h = h; R.dir = dir; R.t_first = dir ? (2047 - LSEG * seg) : LSEG * seg; R.nsteps = LSEG; R.kind = 0;
        R.init = TS + (size_t)(scan * NSEG + seg) * 4096; R.init_ident = 0; R.yout = Y + (size_t)dir * M_ALL * D; R.fin = nullptr;
        scan_run<4, true, true>(p, R, sm, lane, half * 32);
    }
}
DI void phase_rwkv_post(KP p, const WaveCtx& w) {
    const bf16_t* RKV = (const bf16_t*)(p->ws + WS_B); const bf16_t* AA = (const bf16_t*)(p->ws + WS_AA); const bf16_t* Y = (const bf16_t*)(p->ws + WS_Y);
    const bf16_t* Gt = (const bf16_t*)(p->ws + WS_RG); bf16_t* AO = (bf16_t*)(p->ws + WS_RAO);
    for (int u = w.gw; u < M_ALL * 2; u += w.ngw) {
        const int row = u >> 1, c0 = (u & 1) * 512 + w.lane * 8;
        float yf[8], yb[8], r[8], k[8], v[8], a0[8], a1[8], g[8];
        unpack8(*(const u32x4*)(Y + (size_t)row * D + c0), yf); unpack8(*(const u32x4*)(Y + (size_t)(M_ALL + row) * D + c0), yb);
        unpack8(*(const u32x4*)(RKV + (size_t)row * 3072 + c0), r); unpack8(*(const u32x4*)(RKV + (size_t)row * 3072 + 1024 + c0), k); unpack8(*(const u32x4*)(RKV + (size_t)row * 3072 + 2048 + c0), v);
        unpack8(*(const u32x4*)(AA + (size_t)row * D + c0), a0); unpack8(*(const u32x4*)(AA + (size_t)(M_ALL + row) * D + c0), a1);
        unpack8(*(const u32x4*)(Gt + (size_t)row * D + c0), g);
        float y[8], sy = 0.f, bo = 0.f;
#pragma unroll
        for (int e = 0; e < 8; ++e) { y[e] = yf[e] + yb[e]; sy += y[e];
            const float ka = p->in[30][c0 + e]; bo += r[e] * p->in[31][c0 + e] * k[e] * (2.f + (a0[e] + a1[e] - 2.f) * ka); }
        const float mu = sum8(sy) * (1.f / 64.f); bo = sum8(bo);
        float sv = 0.f;
#pragma unroll
        for (int e = 0; e < 8; ++e) { y[e] -= mu; sv += y[e] * y[e]; }
        const float rstd = rsqrtf(sum8(sv) * (1.f / 64.f) + 64e-5f);
        float o[8];
#pragma unroll
        for (int e = 0; e < 8; ++e) o[e] = (y[e] * rstd * p->in[32][c0 + e] + p->in[33][c0 + e] + bo * v[e]) * g[e];
        *(u32x4*)(AO + (size_t)row * D + c0) = pack8(o);
    }
}

#define GAS __attribute__((address_space(1)))
#define XB_TMO      128
#define XB_XCNT(j)  (256  + 64 * (j))
#define XB_XSUB(j)  (1280 + 64 * (j))
#define XB_XGEN(j)  (2304 + 64 * (j))
#define XB_TOP      3328
#define XB_TOPGEN   3392
#define XCD_BAR_WORDS 3456
#define XB_SPIN_CAP (1u << 18)

__device__ __forceinline__ unsigned xb_ld(unsigned* p)              { return __hip_atomic_load(p, __ATOMIC_RELAXED, __HIP_MEMORY_SCOPE_AGENT); }
__device__ __forceinline__ unsigned xb_add(unsigned* p, unsigned v) { return __hip_atomic_fetch_add(p, v, __ATOMIC_RELAXED, __HIP_MEMORY_SCOPE_AGENT); }
__device__ __forceinline__ unsigned xb_xcc_id() { return (unsigned)__builtin_amdgcn_s_getreg((3 << 11) | 20) & 0xFu; }
#define XB_SPIN(cond, bar) do { unsigned _sp = 0; while (cond) { __builtin_amdgcn_s_sleep(1); \
    if ((++_sp & 255u) == 0u) { if (xb_ld(&(bar)[XB_TMO])) break; if (_sp > XB_SPIN_CAP) { atomicAdd(&(bar)[XB_TMO], 1u); break; } } } } while (0)

struct XcdBarrier {
    unsigned* bar; unsigned x;
    volatile LAS unsigned* st;
};

__device__ __forceinline__ XcdBarrier xcd_barrier_post(unsigned* bar, volatile LAS unsigned* st) {
    XcdBarrier b; b.bar = bar; b.x = xb_xcc_id(); b.st = st;
    if (threadIdx.x == 0) (void)xb_add(&bar[XB_XCNT(b.x)], 1u);
    return b;
}
__device__ __forceinline__ void xcd_barrier_complete(unsigned* bar, unsigned x, unsigned& nloc, unsigned& nx) {
    const unsigned G = gridDim.x * gridDim.y * gridDim.z;
    unsigned sum, cnt, mine, sp = 0u;
    for (;;) {
        sum = 0u; cnt = 0u; mine = 0u;
#pragma unroll
        for (unsigned j = 0; j < 16; ++j) { const unsigned c = xb_ld(&bar[XB_XCNT(j)]); sum += c; cnt += (c > 0u) ? 1u : 0u; mine = (j == x) ? c : mine; }
        if (sum == G) break;
        __builtin_amdgcn_s_sleep(1);
        if ((++sp & 255u) == 0u) { if (xb_ld(&bar[XB_TMO])) break; if (sp > XB_SPIN_CAP) { atomicAdd(&bar[XB_TMO], 1u); break; } }
    }
    nloc = mine > 0u ? mine : 1u; nx = cnt > 0u ? cnt : 1u;
}

__device__ __forceinline__ void xcd_barrier(const XcdBarrier& b) {
    asm volatile("s_waitcnt vmcnt(0)" ::: "memory");
    __syncthreads();
    if (threadIdx.x == 0) {
        unsigned* bar = b.bar;
        __builtin_amdgcn_s_waitcnt(0);
        unsigned nloc = b.st[0], nx = b.st[1];
        if (nloc == 0u) { xcd_barrier_complete(bar, b.x, nloc, nx); b.st[0] = nloc; b.st[1] = nx; }
        const unsigned old = xb_add(&bar[XB_XSUB(b.x)], 1u);
        const unsigned gen = old / nloc;
        if (old + 1u == (gen + 1u) * nloc) {
            __builtin_amdgcn_fence(__ATOMIC_RELEASE, "agent");
            asm volatile("s_waitcnt vmcnt(0)" ::: "memory");
            const unsigned og = xb_add(&bar[XB_TOP], 1u);
            const unsigned tg = og / nx;
            if (og + 1u == (tg + 1u) * nx) xb_add(&bar[XB_TOPGEN], 1u);
            else XB_SPIN(xb_ld(&bar[XB_TOPGEN]) == tg, bar);
            __builtin_amdgcn_fence(__ATOMIC_ACQUIRE, "agent");
            xb_add(&bar[XB_XGEN(b.x)], 1u);
            asm volatile("s_waitcnt vmcnt(0)" ::: "memory");
        } else {
            XB_SPIN(xb_ld(&bar[XB_XGEN(b.x)]) == gen, bar);
            __builtin_amdgcn_fence(__ATOMIC_ACQUIRE, "agent");
            asm volatile("s_waitcnt vmcnt(0)" ::: "memory");
        }
    }
    __syncthreads();
}


constexpr int LDS_BYTES = 147456;
constexpr int NPHASES = 36;
constexpr int LDS_BST = 139264;

#ifndef REPMASK
#define REPMASK 0
#endif
#ifndef N_LAUNCH_MODE
#define N_LAUNCH_MODE 1
#endif
enum Op { OP_P0 = 0, OP_NORM, OP_GEMM_QKV, OP_QKPREP, OP_ATTN, OP_GEMM_WO, OP_NORM_R, OP_GEMM_S1, OP_GEMM_S2A, OP_GEMM_S2B, OP_SCAN1, OP_COMBINE, OP_SCAN2, OP_POST, OP_NORM_MLP, OP_GEMM_UP, OP_GEMM_DOWN };
#ifndef PHMASK
#define PHMASK 0xFFFFFFFFu
#endif
__host__ __device__ inline void decode_phase(int pc, int& layer, int& op) {
    if (pc == 0) { layer = 0; op = OP_P0; return; }
    int r = pc - 1;
    if (r < 8) layer = 0; else if (r < 19) { layer = 1; r -= 8; } else if (r < 27) { layer = 2; r -= 19; } else { layer = 3; r -= 27; }
    if (layer != 1) { op = (r < 5) ? (OP_NORM + r) : (OP_NORM_MLP + (r - 5)); }
    else { op = (r < 3) ? (OP_NORM_R + r) : (r < 7 ? OP_SCAN1 + (r - 3) : (r == 7 ? OP_GEMM_WO : OP_NORM_MLP + (r - 8))); }
}
DI void run_op(KP p, int layer, int op, LAS unsigned char* lds, const int tid) {
        const int lane = tid & 63, wave = __builtin_amdgcn_readfirstlane(tid >> 6);
        WaveCtx w; w.gw = blockIdx.x * 8 + wave; w.ngw = gridDim.x * 8; w.lane = lane; w.scr = (LAS float*)(lds + wave * 16384);
        const int kind = layer % 3, j = layer / 3;
        const float* modl = (const float*)(p->ws + WS_MOD) + (size_t)layer * 3 * MODW;
        int gk = 0, nsub = 1;
        const bf16_t* gA = nullptr; const bf16_t* gB = nullptr; int lda = 0, ldb = 0, gN = 0, gK = 0;
        EpiAct EA{nullptr, 0, 0, nullptr, 0, nullptr, nullptr, 0}; EpiRes ER{p->out + O_X, nullptr};
        if (!((PHMASK >> op) & 1u)) op = -1;
        switch (op) {
        case OP_P0: phase_mod(p, lds, tid); convert_mixer_weights(p, w, 0); convert_w1(p, w, 0); convert_w2(p, w, 0); break;
        case OP_NORM: if (layer > 0 && gridDim.x != 256) convert_mixer_weights(p, w, layer); phase_norm(p, w, layer, 0); break;
        case OP_GEMM_QKV: { const int ldq = kind == 0 ? 3072 : 1536; gk = 1; gA = (const bf16_t*)(p->ws + WS_A); lda = D; gB = (const bf16_t*)(p->ws + WS_WQKVT); ldb = D; gN = ldq; gK = D;
            EA.O = (bf16_t*)(p->ws + WS_QKV); EA.ldc = ldq; EA.mode = 0; } break;
        case OP_QKPREP: { const AttnCfg cfg = make_cfg(p, kind, j); phase_qkprep(p, w, cfg, lds + wave * 16384); } break;
        case OP_ATTN: if (kind == 0) phase_attn_da(p, layer, wave, lane, (LAS float*)(lds + wave * 16384)); else phase_attn_swa(p, wave, lane); break;
        case OP_GEMM_WO: gk = 2; gA = (const bf16_t*)(p->ws + (kind == 1 ? WS_RAO : WS_AO)); lda = D; gB = (const bf16_t*)(p->ws + (kind == 1 ? WS_RWO : WS_WOT)); ldb = D; gN = D; gK = D; ER.gate3 = modl + 2 * D; break;
        case OP_NORM_R: if (gridDim.x != 256) convert_mixer_weights(p, w, layer); phase_norm_rwkv(p, w, layer); break;
        case OP_GEMM_S1: gk = 1; nsub = 2; break;
        case OP_GEMM_S2A: gk = 1; nsub = 2; break;
        case OP_SCAN1: phase_scan1(p, (LAS float*)(lds + wave * 12288), wave, lane); break;
        case OP_COMBINE: phase_combine(p, (LAS float*)lds, tid); break;
        case OP_SCAN2: phase_scan2(p, (LAS float*)(lds + wave * 12288), wave, lane); break;
        case OP_POST: phase_rwkv_post(p, w); break;
        case OP_NORM_MLP: if (layer > 0 && gridDim.x != 256) { convert_w1(p, w, layer); convert_w2(p, w, layer); } phase_norm(p, w, layer, 1); break;
        case OP_GEMM_UP: gk = 1; gA = (const bf16_t*)(p->ws + WS_A); lda = D; gB = (const bf16_t*)(p->ws + ws_w1t(layer)); ldb = D; gN = FFD; gK = D;
            EA.O = (bf16_t*)(p->ws + WS_B); EA.ldc = FFD; EA.mode = 1; break;
        case OP_GEMM_DOWN: gk = 2; gA = (const bf16_t*)(p->ws + WS_B); lda = FFD; gB = (const bf16_t*)(p->ws + ws_w2t(layer)); ldb = FFD; gN = D; gK = FFD; ER.gate3 = modl + 5 * D; break;
        default: break;
        }
        if (gk == 1) {
            for (int sub = 0; sub < nsub; ++sub) {
                size_t ags = 0;
                if (op == OP_GEMM_S1) {
                    if (sub == 0) { gA = (const bf16_t*)(p->ws + WS_XS); lda = D; gB = (const bf16_t*)(p->ws + WS_S1T); ldb = 2048; gN = 3072; gK = D; ags = (size_t)M_ALL * D * 2;
                        EA.O = (bf16_t*)(p->ws + WS_B); EA.ldc = 3072; EA.mode = 0; EA.pn_off = 0; }
                    else { gA = (const bf16_t*)(p->ws + WS_A); lda = 2048; gB = (const bf16_t*)(p->ws + WS_S1T) + (size_t)3072 * 2048; ldb = 2048; gN = 512; gK = 2048; ags = 0;
                        EA.O = (bf16_t*)(p->ws + WS_B); EA.ldc = 3072; EA.mode = 2; EA.O2 = (bf16_t*)(p->ws + WS_LORA); EA.ldc2 = 512; EA.pn_off = 12; }
                } else if (op == OP_GEMM_S2A) {
                    if (sub == 0) { gA = (const bf16_t*)(p->ws + WS_LORA); lda = 512; gB = (const bf16_t*)(p->ws + WS_S2T); ldb = 256; gN = 4096; gK = 256;
                        EA.O = (bf16_t*)(p->ws + WS_E); EA.ldc = D; EA.mode = 3; EA.O2 = (bf16_t*)(p->ws + WS_AA); EA.ldc2 = D; EA.b0 = p->in[21]; EA.b1 = p->in[24]; EA.pn_off = 0; }
                    else { gA = (const bf16_t*)(p->ws + WS_LORA) + 256; lda = 512; gB = (const bf16_t*)(p->ws + WS_G2T); ldb = 256; gN = D; gK = 256;
                        EA.O = (bf16_t*)(p->ws + WS_RG); EA.ldc = D; EA.mode = 0; EA.pn_off = 0; }
                }
                run_gemm(lds, gA, lda, gB, ldb, gN, gK, EA, tid, ags);
            }
        }
        else if (gk == 2) {
            run_gemm(lds, gA, lda, gB, ldb, gN, gK, ER, tid);
            if (gridDim.x == 256 && blockIdx.x >= 192 && layer < 3) {
                WaveCtx wi; wi.gw = (blockIdx.x - 192) * 8 + wave; wi.ngw = 512; wi.lane = lane; wi.scr = w.scr;
                if (op == OP_GEMM_WO) convert_w1(p, wi, layer + 1);
                else { convert_w2(p, wi, layer + 1); convert_mixer_weights(p, wi, layer + 1); }
            }
        }
}

#if N_LAUNCH_MODE == 1
__global__ void __launch_bounds__(512, 2) trunk_fwd(Params p_) {
    extern __shared__ __attribute__((aligned(16))) unsigned char lds_raw[];
    LAS unsigned char* lds = (LAS unsigned char*)lds_raw;
    cg::grid_group grid = cg::this_grid();
    const int ph_lo = p_.ph_lo, ph_hi = p_.ph_hi;
    volatile LAS unsigned* bst = (volatile LAS unsigned*)(lds + LDS_BST);
    if (threadIdx.x < 2) bst[threadIdx.x] = 0u;
    __syncthreads();
    XcdBarrier xbar = xcd_barrier_post((unsigned*)(p_.ws + WS_BAR), bst);
    for (int pc = ph_lo; pc < ph_hi; ++pc) {
        KP p = (KP)__builtin_amdgcn_kernarg_segment_ptr(); asm volatile("" : "+s"(p));
        int layer, op; decode_phase(pc, layer, op);
        const int nrep = (((p->repmask >> op) & 1) && ((((p->repmask >> 20) & 0xF) == 0) || ((p->repmask >> (20 + layer)) & 1))) ? 2 : 1;
        for (int rep = 0; rep < nrep; ++rep) {
            int tid = threadIdx.x; asm volatile("" : "+v"(tid));
            run_op(p, layer, op, lds, tid);
        }
        if (pc + 1 < ph_hi) { if (pc == ph_lo) grid.sync(); else { xcd_barrier(xbar); if (p->repmask & 0x40000000) { xcd_barrier(xbar); xcd_barrier(xbar); } } }
    }
}
#else
template <int OP> __global__ void __launch_bounds__(512, 2) k_op(Params p_) {
    extern __shared__ __attribute__((aligned(16))) unsigned char lds_raw[];
    KP p = (KP)__builtin_amdgcn_kernarg_segment_ptr();
    run_op(p, p_.ph_lo, OP, (LAS unsigned char*)lds_raw, threadIdx.x);
}

#endif
extern "C" void kernel_launch(void* const* d_in, const int* in_sizes, int n_in, void* d_out, int out_size, void* d_ws, size_t ws_size, hipStream_t stream) {
    static int grid = 0;
    if (grid == 0) {
        if (n_in != 40 || ws_size < WS_END || out_size != 54525952) { fprintf(stderr, "kernel_launch: unexpected problem (n_in %d, ws %zu, out %d)\n", n_in, ws_size, out_size); grid = -1; return; }
        int dev = 0, cus = 0, per_cu = 0;
        if (hipGetDevice(&dev) != hipSuccess || hipDeviceGetAttribute(&cus, hipDeviceAttributeMultiprocessorCount, dev) != hipSuccess) { grid = -1; return; }
#if N_LAUNCH_MODE == 1
        if (hipFuncSetAttribute((const void*)trunk_fwd, hipFuncAttributeMaxDynamicSharedMemorySize, LDS_BYTES) != hipSuccess) { fprintf(stderr, "kernel_launch: hipFuncSetAttribute failed\n"); grid = -1; return; }
        if (hipOccupancyMaxActiveBlocksPerMultiprocessor(&per_cu, (const void*)trunk_fwd, 512, LDS_BYTES) != hipSuccess || per_cu < 1) { fprintf(stderr, "kernel_launch: occupancy query says %d\n", per_cu); grid = -1; return; }
#else
        per_cu = 1;
#endif
        grid = cus * per_cu;
        if (grid > 256) grid = 256;
    }
    if (grid < 0) return;
    if (hipMemsetAsync((char*)d_ws + WS_BAR, 0, 16384, stream) != hipSuccess) { fprintf(stderr, "kernel_launch: memset failed\n"); return; }
    Params p{};
    for (int i = 0; i < 40; ++i) p.in[i] = (const float*)d_in[i];
    p.out = (float*)d_out; p.ws = (unsigned char*)d_ws; p.repmask = REPMASK; p.pad = 0;
#if N_LAUNCH_MODE == 1
    p.ph_lo = 0; p.ph_hi = NPHASES;
    void* args[] = {&p};
    hipError_t e = hipLaunchCooperativeKernel((const void*)trunk_fwd, dim3(grid), dim3(512), args, LDS_BYTES, stream);
    if (e != hipSuccess) fprintf(stderr, "cooperative launch failed: %s (grid %d)\n", hipGetErrorString(e), grid);
#else
    for (int ph = 0; ph < NPHASES; ++ph) {
        int layer, op; decode_phase(ph, layer, op);
        p.ph_lo = layer; p.ph_hi = 0;
#define LOP(X) case X: { static bool once##X = false; if (!once##X) { (void)hipFuncSetAttribute((const void*)k_op<X>, hipFuncAttributeMaxDynamicSharedMemorySize, LDS_BYTES); once##X = true; } hipLaunchKernelGGL(k_op<X>, dim3(grid), dim3(512), LDS_BYTES, stream, p); } break;
        switch (op) { LOP(0) LOP(1) LOP(2) LOP(3) LOP(4) LOP(5) LOP(6) LOP(7) LOP(8) LOP(9) LOP(10) LOP(11) LOP(12) LOP(13) LOP(14) LOP(15) LOP(16) default: break; }
#undef LOP
    }
#endif
}
```
